# Optimizing an MI355X kernel written in HIP

```python
import math
import jax, jax.numpy as jnp
from jax import lax
import numpy as np

D_MODEL = 1024
BATCH = 1
SEQ = 16384
DEPTH = 2

GRID_W = 64
CTX_LEN = 256
ALPHA = (2 * DEPTH) ** 0.25
BETA = (8 * DEPTH) ** -0.25
LN_EPS = 1e-6
D_FF = ((math.ceil(8 * D_MODEL / 3) + 255) // 256) * 256

RWKV_HEAD = 64
D_A = 3 * D_MODEL // 4
H_A = D_A // RWKV_HEAD
DECAY_LORA = 64
ICL_LORA = 64
GATE_LORA = 128
GN_EPS = 64e-5
D_B = D_MODEL - D_A
POOL_WINDOWS = (2, 4, 8, 16)
POOL_GROUP = D_B // len(POOL_WINDOWS)
C_RW = 3 * D_A + 2 * DECAY_LORA + 2 * ICL_LORA + GATE_LORA
D_IN_EVEN = C_RW + D_B
NA_HEAD = 64
H_C = D_MODEL // NA_HEAD
NA_KH = 8
NA_KW = 16

N_EVEN = (DEPTH + 1) // 2
N_ODD = DEPTH // 2

kernel_name = 'rwkv7_pool_natten_hybrid_dit'


def layer_norm(x, g, b):
    xf = x.astype(jnp.float32)
    mu = xf.mean(-1, keepdims=True)
    var = jnp.mean(jnp.square(xf - mu), -1, keepdims=True)
    return ((xf - mu) * lax.rsqrt(var + LN_EPS)).astype(x.dtype) * g + b


def swiglu(h, w1, w3, w2):
    return (jax.nn.silu(h @ w1) * (h @ w3)) @ w2


def centred_shift_mix(p, mu):
    zero = jnp.zeros_like(p[:, :1])
    prev = jnp.concatenate([zero, p[:, :-1]], axis=1)
    nxt = jnp.concatenate([p[:, 1:], zero], axis=1)
    return p + (prev - p) * mu[0] + (nxt - p) * mu[1]


def rwkv_prepare(p, mu, w0, w2, a0, a2, g2, k_k, k_a):
    B, T, _ = p.shape
    p = centred_shift_mix(p, mu)
    s1 = D_A; s2 = 2 * D_A; s3 = 3 * D_A; s4 = s3 + 2 * DECAY_LORA; s5 = s4 + 2 * ICL_LORA
    r, k, v, wd, ad, gd = jnp.split(p, [s1, s2, s3, s4, s5], axis=-1)
    wd = wd.reshape(B, T, 2, DECAY_LORA)
    ad = ad.reshape(B, T, 2, ICL_LORA)
    f32 = jnp.float32
    logw = -jax.nn.softplus(-(w0 + jnp.einsum('btdr,drc->btdc', jnp.tanh(wd), w2)).astype(f32)) - 0.5
    decay = jnp.exp(-jnp.exp(logw))
    a = jax.nn.sigmoid((a0 + jnp.einsum('btdr,drc->btdc', ad, a2)).astype(f32))
    g = jax.nn.sigmoid(gd) @ g2
    r = r.astype(f32); k = k.astype(f32); v = v.astype(f32)
    kk = (k * k_k).reshape(B, T, H_A, RWKV_HEAD)
    kk = kk / jnp.maximum(jnp.linalg.norm(kk, axis=-1, keepdims=True), 1e-12)
    kd = k[:, :, None, :] * (1.0 + (a - 1.0) * k_a)
    bd = kk.reshape(B, T, 1, D_A) * a
    hs = (B, T, 2, H_A, RWKV_HEAD)
    return (r.reshape(B, T, H_A, RWKV_HEAD), v.reshape(B, T, H_A, RWKV_HEAD), kk,
            decay.reshape(hs), kd.reshape(hs), bd.reshape(hs), g)


def wkv_scan(S0, r, w, k, v, kk, b, reverse):
    def step(S, inp):
        r_t, w_t, k_t, v_t, kk_t, b_t = inp
        sa = -jnp.einsum('bhij,bhj->bhi', S, kk_t)
        S = S * w_t[:, :, None, :] + sa[..., :, None] * b_t[:, :, None, :] + v_t[..., :, None] * k_t[:, :, None, :]
        return S, jnp.einsum('bhij,bhj->bhi', S, r_t)
    xs = tuple(jnp.swapaxes(t, 0, 1) for t in (r, w, k, v, kk, b))
    S, ys = lax.scan(step, S0, xs, reverse=reverse)
    return S, jnp.swapaxes(ys, 0, 1)


def rwkv_readout(y, r, v, kd, g, r_k, lnx_g, lnx_b):
    B, T = y.shape[:2]
    mu = y.mean(-1, keepdims=True)
    var = jnp.mean(jnp.square(y - mu), -1, keepdims=True)
    yn = ((y - mu) * lax.rsqrt(var + GN_EPS)).reshape(B, T, D_A) * lnx_g + lnx_b
    coef = jnp.sum(r[:, :, None] * kd * r_k, axis=(2, 4))
    bonus = (coef[..., None] * v).reshape(B, T, D_A)
    return ((yn + bonus) * g).astype(g.dtype)


def multiscale_pool(p, pool_w, pool_scale):
    B, T, _ = p.shape
    pf = p.astype(jnp.float32)
    cs = jnp.concatenate([jnp.zeros((B, 1, D_B), jnp.float32), jnp.cumsum(pf, axis=1)], axis=1)
    t = jnp.arange(T)
    groups = []
    for gi, win in enumerate(POOL_WINDOWS):
        lo = jnp.clip(t - win // 2, 0, T)
        hi = jnp.clip(t + win // 2, 0, T)
        sl = slice(gi * POOL_GROUP, (gi + 1) * POOL_GROUP)
        cg = cs[:, :, sl]
        mean = (cg[:, hi] - cg[:, lo]) / (hi - lo).astype(jnp.float32)[None, :, None]
        groups.append(mean - pf[:, :, sl])
    pooled = jnp.stack(groups, axis=2).astype(p.dtype)
    y = jnp.einsum('btgc,gcd->btgd', pooled, pool_w).reshape(B, T, D_B)
    return y * pool_scale


def rwkv_pool_mixer(h, hc, want_ctx, w_in, shift_mu, w0, w2, a0, a2, g2, k_k, k_a, r_k,
                    lnx_g, lnx_b, pool_w, pool_scale, w_out):
    B = h.shape[0]
    p_lat = h @ w_in
    p_ctx = hc @ w_in
    lat = rwkv_prepare(p_lat[..., :C_RW], shift_mu, w0, w2, a0, a2, g2, k_k, k_a)
    cx = rwkv_prepare(p_ctx[..., :C_RW], shift_mu, w0, w2, a0, a2, g2, k_k, k_a)
    S0 = jnp.zeros((B, H_A, RWKV_HEAD, RWKV_HEAD), jnp.float32)
    y_lat = 0.0
    y_ctx = 0.0
    for d in range(2):
        rev = d == 1
        S_c, yc = wkv_scan(S0, cx[0], cx[3][:, :, d], cx[4][:, :, d], cx[1], cx[2], cx[5][:, :, d], rev)
        _, yl = wkv_scan(S_c, lat[0], lat[3][:, :, d], lat[4][:, :, d], lat[1], lat[2], lat[5][:, :, d], rev)
        y_lat = y_lat + yl
        if want_ctx:
            y_ctx = y_ctx + yc
    a_lat = rwkv_readout(y_lat, lat[0], lat[1], lat[4], lat[6], r_k, lnx_g, lnx_b)
    b_lat = multiscale_pool(p_lat[..., C_RW:], pool_w, pool_scale)
    out_lat = jnp.concatenate([a_lat, b_lat], axis=-1) @ w_out
    if not want_ctx:
        return out_lat, None
    a_ctx = rwkv_readout(y_ctx, cx[0], cx[1], cx[4], cx[6], r_k, lnx_g, lnx_b)
    b_ctx = multiscale_pool(p_ctx[..., C_RW:], pool_w, pool_scale)
    out_ctx = jnp.concatenate([a_ctx, b_ctx], axis=-1) @ w_out
    return out_lat, out_ctx


def neighbourhood_attention(q, k, v, kc, vc, rpb):
    B, rows = q.shape[:2]
    kh = min(NA_KH, rows)
    kw = NA_KW
    n_loc = kh * kw
    scale = NA_HEAD ** -0.5
    cols = jnp.arange(GRID_W)
    col_start = jnp.clip(cols - kw // 2, 0, GRID_W - kw)
    col_idx = col_start[:, None] + jnp.arange(kw)[None, :]
    col_off = col_idx - cols[:, None] + (NA_KW - 1)

    def row_block(r):
        sr = jnp.clip(r - kh // 2, 0, rows - kh)
        qr = lax.dynamic_index_in_dim(q, r, axis=1, keepdims=False)
        kr = lax.dynamic_slice_in_dim(k, sr, kh, axis=1)
        vr = lax.dynamic_slice_in_dim(v, sr, kh, axis=1)
        kg = jnp.take(kr, col_idx, axis=2).transpose(0, 2, 1, 3, 4, 5).reshape(B, GRID_W, n_loc, H_C, NA_HEAD)
        vg = jnp.take(vr, col_idx, axis=2).transpose(0, 2, 1, 3, 4, 5).reshape(B, GRID_W, n_loc, H_C, NA_HEAD)
        row_off = sr - r + jnp.arange(kh) + (NA_KH - 1)
        bias = rpb[:, row_off[:, None, None], col_off[None, :, :]]
        bias = bias.transpose(0, 2, 1, 3).reshape(H_C, GRID_W, n_loc).astype(jnp.float32)
        s_loc = jnp.einsum('bqhd,bqnhd->bhqn', qr, kg).astype(jnp.float32) * scale + bias
        s_ctx = jnp.einsum('bqhd,bnhd->bhqn', qr, kc).astype(jnp.float32) * scale
        p = jax.nn.softmax(jnp.concatenate([s_loc, s_ctx], axis=-1), axis=-1).astype(v.dtype)
        return (jnp.einsum('bhqn,bqnhd->bqhd', p[..., :n_loc], vg)
                + jnp.einsum('bhqn,bnhd->bqhd', p[..., n_loc:], vc))

    o = lax.map(row_block, jnp.arange(rows))
    return jnp.moveaxis(o, 0, 1)


def na_mixer(h, hc, want_ctx, w_in, rpb, w_out):
    B, L, D = h.shape
    rows = L // GRID_W
    n_ctx = hc.shape[1]
    q, k, v = jnp.split(h @ w_in, 3, axis=-1)
    kc, vc = jnp.split(hc @ w_in[:, D:], 2, axis=-1)
    kc = kc.reshape(B, n_ctx, H_C, NA_HEAD)
    vc = vc.reshape(B, n_ctx, H_C, NA_HEAD)
    gs = (B, rows, GRID_W, H_C, NA_HEAD)
    o = neighbourhood_attention(q.reshape(gs), k.reshape(gs), v.reshape(gs), kc, vc, rpb)
    out_lat = o.reshape(B, L, D) @ w_out
    if not want_ctx:
        return out_lat, None
    qc = (hc @ w_in[:, :D]).reshape(B, n_ctx, H_C, NA_HEAD)
    s = jnp.einsum('bqhd,bkhd->bhqk', qc, kc).astype(jnp.float32) * NA_HEAD ** -0.5
    p = jax.nn.softmax(s, axis=-1).astype(vc.dtype)
    oc = jnp.einsum('bhqk,bkhd->bqhd', p, vc).reshape(B, n_ctx, D)
    return out_lat, oc @ w_out


def setup_inputs(seed: int = 0) -> dict:
    key = jax.random.key(seed)
    ks = jax.random.split(key, 32)
    D = D_MODEL
    f32 = jnp.float32

    def n(k, shape, s):
        return jax.random.normal(k, shape, f32) * s

    return {
        'x': n(ks[0], (BATCH, SEQ, D), 1.0),
        'c': n(ks[1], (BATCH, D), 1.0),
        'ctx': n(ks[2], (BATCH, CTX_LEN, D), 1.0),
        'c_ctx': n(ks[3], (D,), 1.0),
        'ada_w': n(ks[4], (DEPTH, D, 6 * D), 0.5 * D ** -0.5),
        'ada_b': n(ks[5], (DEPTH, 6 * D), 0.02),
        'ln_g': 1.0 + n(ks[6], (DEPTH, 2, D), 0.05),
        'ln_b': n(ks[7], (DEPTH, 2, D), 0.02),
        'ffn_w1': n(ks[8], (DEPTH, D, D_FF), D ** -0.5),
        'ffn_w3': n(ks[9], (DEPTH, D, D_FF), D ** -0.5),
        'ffn_w2': n(ks[10], (DEPTH, D_FF, D), BETA * D_FF ** -0.5),
        'ev_w_in': n(ks[11], (N_EVEN, D, D_IN_EVEN), D ** -0.5),
        'ev_shift_mu': jax.random.uniform(ks[12], (N_EVEN, 2, C_RW), f32, 0.0, 0.5),
        'ev_w0': jax.random.uniform(ks[13], (N_EVEN, 2, D_A), f32, -6.5, -1.5),
        'ev_w2': n(ks[14], (N_EVEN, 2, DECAY_LORA, D_A), 0.5 * DECAY_LORA ** -0.5),
        'ev_a0': n(ks[15], (N_EVEN, 2, D_A), 0.1),
        'ev_a2': n(ks[16], (N_EVEN, 2, ICL_LORA, D_A), 0.5 * ICL_LORA ** -0.5),
        'ev_g2': n(ks[17], (N_EVEN, GATE_LORA, D_A), GATE_LORA ** -0.5),
        'ev_k_k': 0.85 + n(ks[18], (N_EVEN, D_A), 0.05),
        'ev_k_a': 1.0 + n(ks[19], (N_EVEN, D_A), 0.05),
        'ev_r_k': n(ks[20], (N_EVEN, H_A, RWKV_HEAD), 0.1),
        'ev_lnx_g': 1.0 + n(ks[21], (N_EVEN, D_A), 0.05),
        'ev_lnx_b': n(ks[22], (N_EVEN, D_A), 0.02),
        'ev_pool_w': n(ks[23], (N_EVEN, len(POOL_WINDOWS), POOL_GROUP, POOL_GROUP), POOL_GROUP ** -0.5),
        'ev_pool_scale': 1.0 + n(ks[24], (N_EVEN, D_B), 0.1),
        'ev_w_out': n(ks[25], (N_EVEN, D, D), BETA * D ** -0.5),
        'od_w_in': n(ks[26], (N_ODD, D, 3 * D), D ** -0.5),
        'od_rpb': n(ks[27], (N_ODD, H_C, 2 * NA_KH - 1, 2 * NA_KW - 1), 0.05),
        'od_w_out': n(ks[28], (N_ODD, D, D), BETA * D ** -0.5),
    }


def reference(x, c, ctx, c_ctx, ada_w, ada_b, ln_g, ln_b, ffn_w1, ffn_w3, ffn_w2,
              ev_w_in, ev_shift_mu, ev_w0, ev_w2, ev_a0, ev_a2, ev_g2, ev_k_k, ev_k_a, ev_r_k,
              ev_lnx_g, ev_lnx_b, ev_pool_w, ev_pool_scale, ev_w_out,
              od_w_in, od_rpb, od_w_out):
    xc = ctx
    for i in range(DEPTH):
        last = i == DEPTH - 1
        want_ctx = not last
        j = i // 2
        mod = jax.nn.silu(c) @ ada_w[i] + ada_b[i]
        mod_c = jax.nn.silu(c_ctx) @ ada_w[i] + ada_b[i]
        sh_m, sc_m, g_m, sh_f, sc_f, g_f = jnp.split(mod[:, None, :], 6, axis=-1)
        shc_m, scc_m, gc_m, shc_f, scc_f, gc_f = jnp.split(mod_c, 6, axis=-1)
        h = x * (1.0 + sc_m) + sh_m
        hc = xc * (1.0 + scc_m) + shc_m
        if i % 2 == 0:
            y, yc = rwkv_pool_mixer(h, hc, want_ctx, ev_w_in[j], ev_shift_mu[j], ev_w0[j], ev_w2[j],
                                    ev_a0[j], ev_a2[j], ev_g2[j], ev_k_k[j], ev_k_a[j], ev_r_k[j],
                                    ev_lnx_g[j], ev_lnx_b[j], ev_pool_w[j], ev_pool_scale[j], ev_w_out[j])
        else:
            y, yc = na_mixer(h, hc, want_ctx, od_w_in[j], od_rpb[j], od_w_out[j])
        x = layer_norm(ALPHA * x + g_m * y, ln_g[i, 0], ln_b[i, 0])
        h = x * (1.0 + sc_f) + sh_f
        x = layer_norm(ALPHA * x + g_f * swiglu(h, ffn_w1[i], ffn_w3[i], ffn_w2[i]), ln_g[i, 1], ln_b[i, 1])
        if want_ctx:
            xc = layer_norm(ALPHA * xc + gc_m * yc, ln_g[i, 0], ln_b[i, 0])
            hc = xc * (1.0 + scc_f) + shc_f
            xc = layer_norm(ALPHA * xc + gc_f * swiglu(hc, ffn_w1[i], ffn_w3[i], ffn_w2[i]), ln_g[i, 1], ln_b[i, 1])
    return x
```

```cpp
#define DEPC_ 3
#define DEPA_ 2
#define PFA 1
#include <hip/hip_runtime.h>
#include <hip/hip_cooperative_groups.h>
#include <cstdio>
#include <cstdint>
namespace cg = cooperative_groups;
namespace pg8 {
#define PG8_LAS __attribute__((address_space(3)))
typedef unsigned short bf16_t;
typedef short bf16x8 __attribute__((ext_vector_type(8)));
typedef float f32x4 __attribute__((ext_vector_type(4)));
typedef unsigned u32x4 __attribute__((ext_vector_type(4)));
constexpr int BM = 256, BK = 64, HALF = 128, HTB = HALF * BK * 2  , STAGE_BYTES = 8 * HTB, NXCD = 8, WGM = 8;

__host__ __device__ __forceinline__ int lds_byte(int r, int c) { const int st = (r >> 4) * 2 + (c >> 5), rr = r & 15, cc = c & 31, ob = rr * 64 + cc * 2; return st * 1024 + (ob ^ (((ob >> 9) & 1) << 5)); }
__host__ __device__ __forceinline__ void stage_rc(int b, int& R, int& C) { const int st = b / 1024, sb = b % 1024, swz = sb ^ (((sb >> 9) & 1) << 5); R = (st >> 1) * 16 + swz / 64; C = (st & 1) * 32 + (swz % 64) / 2; }
__host__ __device__ __forceinline__ int perm32(int rho) { const int n = rho >> 4, i = rho & 15; return 8 * (i >> 2) + 4 * n + (i & 3); }

struct Unit { int pm, pn; };
struct Gemm { const bf16_t* A; const bf16_t* Bt; int M, N, K, ld; };

struct StaticOrder {
    int nM, nN, nwg, G, c;
    __host__ __device__ void init(int M, int N, int G_, int c_) { nM = M / BM; nN = N / BM; nwg = nM * nN; G = G_; c = c_; }
    __host__ __device__ bool next(int i, Unit& u) const {
        const long L = (long)i * G + c; if (L >= nwg) return false;
        int wgid = (int)L; { const int q = nwg / NXCD, r = nwg % NXCD, xcd = wgid % NXCD, off = wgid / NXCD; wgid = (xcd < r ? xcd * (q + 1) : r * (q + 1) + (xcd - r) * q) + off; }
        const int nig = WGM * nN, gid = wgid / nig, fm = gid * WGM, gsz = (nM - fm) < WGM ? (nM - fm) : WGM;
        u.pm = fm + ((wgid % nig) % gsz); u.pn = (wgid % nig) / gsz; return true;
    }
    __device__ __forceinline__ void a_ready(const Unit&) const {}
    __device__ __forceinline__ void done(const Unit&) const {}
};

__device__ __forceinline__ unsigned cvt_pk_bf16(float lo, float hi) { unsigned r; asm volatile("v_cvt_pk_bf16_f32 %0, %1, %2" : "=v"(r) : "v"(lo), "v"(hi)); return r; }
template <class Epi, class Sched, bool ALIGN_EPI = false, bool SP2 = false>
__device__ __forceinline__ void gemm_phase(PG8_LAS unsigned char* lds, const Gemm g, const Sched& S, const Epi& E) {
    const int tid = threadIdx.x, wid = __builtin_amdgcn_readfirstlane(tid >> 6), lane = tid & 63, wr = wid >> 2, wc = wid & 3, fr = lane & 15, fq = lane >> 4;
    const int K = g.K, nt = K / BK, LD = g.ld;
    unsigned voffA[2], voffB[2];
#pragma unroll
    for (int i = 0; i < 2; ++i) { int R, C; stage_rc(tid * 16 + i * 8192, R, C); const int Rb = Epi::PERM ? ((R & ~31) + perm32(R & 31)) : R;
        voffA[i] = (unsigned)(R * LD + C) * 2u; voffB[i] = (unsigned)(Rb * LD + C) * 2u; }
    const size_t kstep = (size_t)(BK * 2);
    const size_t hstep = (size_t)HALF * LD * 2;
    const size_t tstep = 2 * hstep;
    const unsigned ldsw = (unsigned)wid * 1024u;
    const int aoff = lds_byte(wr * 64 + fr, fq * 8), boff = lds_byte(wc * 32 + fr, fq * 8);
#define PG8_SA(b, h) (((b) * 2 + (h)) * HTB)
#define PG8_SB(b, h) ((4 + (b) * 2 + (h)) * HTB)
#define PG8_STAGE(bufoff, gbase, voff) do { _Pragma("unroll") for (int _i = 0; _i < 2; ++_i) \
        __builtin_amdgcn_global_load_lds((const unsigned*)((const char*)(gbase) + (voff)[_i]), (PG8_LAS unsigned*)(lds + (bufoff) + ldsw + _i * 8192), 16, 0, 0); } while (0)
#define PG8_LDA(dst, b, h) do { _Pragma("unroll") for (int m = 0; m < 4; ++m) _Pragma("unroll") for (int k = 0; k < 2; ++k) dst[m][k] = *(const PG8_LAS bf16x8*)(lds + PG8_SA(b, h) + aoff + m * 2048 + k * 1024); } while (0)
#define PG8_LDB(dst, b, h) do { _Pragma("unroll") for (int n = 0; n < 2; ++n) _Pragma("unroll") for (int k = 0; k < 2; ++k) dst[n][k] = *(const PG8_LAS bf16x8*)(lds + PG8_SB(b, h) + boff + n * 2048 + k * 1024); } while (0)
#define PG8_MMA(ai, bj, At, Bt) do { __builtin_amdgcn_s_setprio(1); _Pragma("unroll") for (int m = 0; m < 4; ++m) _Pragma("unroll") for (int n = 0; n < 2; ++n) _Pragma("unroll") for (int k = 0; k < 2; ++k) \
        acc[ai][bj][m][n] = __builtin_amdgcn_mfma_f32_16x16x32_bf16(Bt[n][k], At[m][k], acc[ai][bj][m][n], 0, 0, 0); __builtin_amdgcn_s_setprio(0); } while (0)
#define PG8_WAIT_V(n) asm volatile("s_waitcnt vmcnt(" #n ")" ::: "memory")
#define PG8_WAIT_L(n) asm volatile("s_waitcnt lgkmcnt(" #n ")" ::: "memory")
#define PG8_BAR __builtin_amdgcn_s_barrier()
#define PG8_SCHED __builtin_amdgcn_sched_barrier(0)
    Unit cur, nxt; int ui = 0;
    if (!S.next(0, cur)) return;
    f32x4 acc[2][2][4][2];
#pragma unroll
    for (int a = 0; a < 2; ++a)
#pragma unroll
        for (int b = 0; b < 2; ++b)
#pragma unroll
            for (int m = 0; m < 4; ++m)
#pragma unroll
                for (int n = 0; n < 2; ++n) acc[a][b][m][n] = (f32x4){0.f, 0.f, 0.f, 0.f};
    bf16x8 At[4][2], B0[2][2], B1[2][2];
    const char* cA = (const char*)g.A + (size_t)cur.pm * tstep; const char* cB = (const char*)g.Bt + (size_t)cur.pn * tstep;
    S.a_ready(cur);
    if constexpr (SP2) {
        PG8_STAGE(PG8_SB(0, 0), cB, voffB); PG8_STAGE(PG8_SB(0, 1), cB + hstep, voffB); PG8_STAGE(PG8_SA(0, 0), cA, voffA); PG8_STAGE(PG8_SA(0, 1), cA + hstep, voffA);
        if (wr == 1) PG8_BAR;
        PG8_WAIT_V(2); PG8_BAR;
        PG8_STAGE(PG8_SB(1, 0), cB + kstep, voffB); PG8_STAGE(PG8_SA(1, 0), cA + kstep, voffA); PG8_STAGE(PG8_SB(1, 1), cB + hstep + kstep, voffB);
        PG8_WAIT_V(6); PG8_BAR;
    } else {
        PG8_STAGE(PG8_SB(0, 0), cB, voffB); PG8_STAGE(PG8_SA(0, 0), cA, voffA); PG8_STAGE(PG8_SB(0, 1), cB + hstep, voffB); PG8_STAGE(PG8_SA(0, 1), cA + hstep, voffA);
        if (wr == 1) PG8_BAR;
        PG8_WAIT_V(4); PG8_BAR;
        PG8_STAGE(PG8_SB(1, 0), cB + kstep, voffB); PG8_STAGE(PG8_SA(1, 0), cA + kstep, voffA); PG8_STAGE(PG8_SB(1, 1), cB + hstep + kstep, voffB);
        PG8_WAIT_V(6); PG8_BAR;
    }
    for (;;) {
        const bool has_next = S.next(ui + 1, nxt);
        const char* nA = has_next ? (const char*)g.A + (size_t)nxt.pm * tstep : cA; const char* nB = has_next ? (const char*)g.Bt + (size_t)nxt.pn * tstep : cB;
        for (int t = 0; t < nt; t += 2) {
            const bool last = (t == nt - 2);
            const char* a1 = cA + (size_t)(t + 1) * kstep;
            const char* a2 = last ? nA : cA + (size_t)(t + 2) * kstep; const char* b2 = last ? nB : cB + (size_t)(t + 2) * kstep;
            const char* a3 = a2 + kstep; const char* b3 = b2 + kstep;
            if (last && has_next) S.a_ready(nxt);
            if constexpr (SP2) {
            PG8_LDB(B0, 0, 0); PG8_LDB(B1, 0, 1); PG8_SCHED; PG8_LDA(At, 0, 0); PG8_STAGE(PG8_SA(1, 1), a1 + hstep, voffA);
            PG8_WAIT_V(8); PG8_WAIT_L(0); PG8_BAR; PG8_MMA(0, 0, At, B0); PG8_MMA(0, 1, At, B1); PG8_BAR; PG8_SCHED;
            PG8_LDA(At, 0, 1); PG8_STAGE(PG8_SB(0, 0), b2, voffB); PG8_STAGE(PG8_SB(0, 1), b2 + hstep, voffB); PG8_STAGE(PG8_SA(0, 0), a2, voffA);
            PG8_WAIT_V(8); PG8_WAIT_L(0); PG8_BAR; PG8_MMA(1, 0, At, B0); PG8_MMA(1, 1, At, B1); PG8_BAR; PG8_SCHED;
            PG8_LDB(B0, 1, 0); PG8_LDB(B1, 1, 1); PG8_SCHED; PG8_LDA(At, 1, 0); PG8_STAGE(PG8_SA(0, 1), a2 + hstep, voffA);
            PG8_WAIT_V(8); PG8_WAIT_L(0); PG8_BAR; PG8_MMA(0, 0, At, B0); PG8_MMA(0, 1, At, B1); PG8_BAR; PG8_SCHED;
            PG8_LDA(At, 1, 1); PG8_STAGE(PG8_SB(1, 0), b3, voffB); PG8_STAGE(PG8_SB(1, 1), b3 + hstep, voffB); PG8_STAGE(PG8_SA(1, 0), a3, voffA);
            PG8_WAIT_V(8); PG8_WAIT_L(0); PG8_BAR; PG8_MMA(1, 0, At, B0); PG8_MMA(1, 1, At, B1); PG8_BAR; PG8_SCHED;
            } else {
            PG8_LDB(B0, 0, 0); PG8_SCHED; PG8_LDA(At, 0, 0); PG8_STAGE(PG8_SA(1, 1), a1 + hstep, voffA);
            PG8_WAIT_L(8); PG8_BAR; PG8_WAIT_L(0); PG8_MMA(0, 0, At, B0); PG8_BAR; PG8_SCHED;
            PG8_LDB(B1, 0, 1); PG8_STAGE(PG8_SB(0, 0), b2, voffB);
            PG8_BAR; PG8_WAIT_L(0); PG8_MMA(0, 1, At, B1); PG8_BAR;
            PG8_LDA(At, 0, 1); PG8_STAGE(PG8_SA(0, 0), a2, voffA);
            PG8_BAR; PG8_WAIT_L(0); PG8_MMA(1, 0, At, B0); PG8_BAR; PG8_SCHED;
            PG8_STAGE(PG8_SB(0, 1), b2 + hstep, voffB);
            PG8_WAIT_V(6); PG8_BAR; PG8_MMA(1, 1, At, B1); PG8_BAR;
            PG8_LDB(B0, 1, 0); PG8_SCHED; PG8_LDA(At, 1, 0); PG8_STAGE(PG8_SA(0, 1), a2 + hstep, voffA);
            PG8_WAIT_L(8); PG8_BAR; PG8_WAIT_L(0); PG8_MMA(0, 0, At, B0); PG8_BAR; PG8_SCHED;
            PG8_LDB(B1, 1, 1); PG8_STAGE(PG8_SB(1, 0), b3, voffB);
            PG8_BAR; PG8_WAIT_L(0); PG8_MMA(0, 1, At, B1); PG8_BAR;
            PG8_LDA(At, 1, 1); PG8_STAGE(PG8_SA(1, 0), a3, voffA);
            PG8_BAR; PG8_WAIT_L(0); PG8_MMA(1, 0, At, B0); PG8_BAR; PG8_SCHED;
            PG8_STAGE(PG8_SB(1, 1), b3 + hstep, voffB);
            PG8_WAIT_V(6); PG8_BAR; PG8_MMA(1, 1, At, B1); PG8_BAR;
            }
        }
        if constexpr (ALIGN_EPI) { if (wr == 0) PG8_BAR; }
        if constexpr (!Epi::AFTER_DRAIN) { E(acc, cur, wr, wc, fr, fq); S.done(cur); }
        if (!has_next) break;
#pragma unroll
        for (int a = 0; a < 2; ++a)
#pragma unroll
            for (int b = 0; b < 2; ++b)
#pragma unroll
                for (int m = 0; m < 4; ++m)
#pragma unroll
                    for (int n = 0; n < 2; ++n) acc[a][b][m][n] = (f32x4){0.f, 0.f, 0.f, 0.f};
        cur = nxt; cA = nA; cB = nB; ++ui;
        if constexpr (ALIGN_EPI) { if (wr == 1) PG8_BAR; }
    }
    PG8_WAIT_V(0);
    if constexpr (!ALIGN_EPI) { if (wr == 0) PG8_BAR; }
    PG8_BAR;
    if constexpr (Epi::AFTER_DRAIN) { E.fused(acc, cur, wr, wc, fr, fq, lds, wid, lane); S.done(cur); }
#undef PG8_SA
#undef PG8_SB
#undef PG8_STAGE
#undef PG8_LDA
#undef PG8_LDB
#undef PG8_MMA
#undef PG8_WAIT_V
#undef PG8_WAIT_L
#undef PG8_BAR
#undef PG8_SCHED
}
}
using pg8::bf16_t; using pg8::bf16x8; using pg8::f32x4; using pg8::Unit;
typedef float f32x2 __attribute__((ext_vector_type(2)));
typedef unsigned u32x4 __attribute__((ext_vector_type(4)));
typedef unsigned u32x2 __attribute__((ext_vector_type(2)));

constexpr int TL = 16384, TC = 256, T = TL + TC, D = 1024, DFF = 2816, DA = 768;
constexpr int PLD = 3072;
constexpr int NC = 80, CH = 208, NS = 8;
constexpr float ALPHA = 1.41421356237f, LN_EPS = 1e-6f, GN_EPS = 64e-5f;
constexpr int KS = 8;
constexpr size_t OFF_PBUF = 0, OFF_Z = 0, OFF_QK = 0;
constexpr size_t OFF_HID = 68157440ull, OFF_VT = 68157440ull;
constexpr size_t OFF_PQ = 102236160ull, OFF_Y = 165150720ull, OFF_AG = 216268800ull;
constexpr size_t OFF_XA = 161873920ull, OFF_HBUF = 230031360ull;
constexpr size_t OFF_MODP = 264110080ull, OFF_MODR = OFF_MODP + 786432ull, OFF_COEF = OFF_MODR + 98304ull, OFF_BAR = OFF_COEF + 1597440ull, WS_END = OFF_BAR + 16384ull;
constexpr size_t WO_WIN0 = 0, WO_WO0 = 6291456, WO_WUP0 = 8388608, WO_WDN0 = 19922944, WO_WIN1 = 25690112, WO_WO1 = 31981568, WO_WUP1 = 34078720, WO_WDN1 = 45613056,
                 WO_W2T = 51380224, WO_A2T = 51576832, WO_BG = 51773440, WO_PART = 52559872;
constexpr int WAVE_LDS = 16896, LDS_BAR_OFF = 8 * WAVE_LDS + 22272, LDS_BYTES = LDS_BAR_OFF + 16;

struct Args { const float* in[29]; float* out; unsigned char* ws; int lo, hi; };

__device__ __forceinline__ unsigned f2bf(float f) { unsigned u = __builtin_bit_cast(unsigned, f); return (u + 0x7fffu + ((u >> 16) & 1u)) >> 16; }
__device__ __forceinline__ float bf2f(unsigned short b) { return __builtin_bit_cast(float, ((unsigned)b) << 16); }
__device__ __forceinline__ unsigned pk2(float lo, float hi) { return f2bf(lo) | (f2bf(hi) << 16); }
template <int CTRL> __device__ __forceinline__ float dppf(float x) { return __builtin_bit_cast(float, __builtin_amdgcn_update_dpp(0, __builtin_bit_cast(int, x), CTRL, 0xf, 0xf, true)); }
__device__ __forceinline__ float sum16(float v) { v += dppf<0xB1>(v); v += dppf<0x4E>(v); v += dppf<0x124>(v); v += dppf<0x128>(v); return v; }
__device__ __forceinline__ float xsum16(float v) { return v + __shfl_xor(v, 16); }
__device__ __forceinline__ float xsum32(float v) { return v + __shfl_xor(v, 32); }
__device__ __forceinline__ float xmax16(float v) { return fmaxf(v, __shfl_xor(v, 16)); }
__device__ __forceinline__ float xmax32(float v) { return fmaxf(v, __shfl_xor(v, 32)); }
__device__ __forceinline__ float wsum(float v) { return xsum32(xsum16(sum16(v))); }
__device__ __forceinline__ float rcp_(float x) { return __builtin_amdgcn_rcpf(x); }
__device__ __forceinline__ float sigm(float x) { return rcp_(1.f + __expf(-x)); }
__device__ __forceinline__ void wave_sync() { __builtin_amdgcn_fence(__ATOMIC_SEQ_CST, "wavefront"); __builtin_amdgcn_wave_barrier(); }

struct EpiStore {
    static constexpr bool PERM = true, AFTER_DRAIN = false;
    bf16_t* O; int ldc;
    __device__ __forceinline__ void operator()(const f32x4 (&acc)[2][2][4][2], const Unit& u, int wr, int wc, int fr, int fq) const {
        const int row0 = u.pm * 256 + wr * 64 + fr, col0 = u.pn * 256 + wc * 32 + 8 * fq;
#pragma unroll
        for (int ai = 0; ai < 2; ++ai)
#pragma unroll
            for (int m = 0; m < 4; ++m) { bf16_t* rp = O + (size_t)(row0 + ai * 128 + m * 16) * ldc + col0;
#pragma unroll
                for (int bj = 0; bj < 2; ++bj) { const f32x4 a = acc[ai][bj][m][0], b = acc[ai][bj][m][1]; u32x4 w; w.x = pk2(a[0], a[1]); w.y = pk2(a[2], a[3]); w.z = pk2(b[0], b[1]); w.w = pk2(b[2], b[3]); *(u32x4*)(rp + bj * 128) = w; } }
    }
};
struct EpiQKV {
    static constexpr bool PERM = true, AFTER_DRAIN = false;
    bf16_t* QK; bf16_t* Vt;
    __device__ __forceinline__ void operator()(const f32x4 (&acc)[2][2][4][2], const Unit& u, int wr, int wc, int fr, int fq) const {
        const int row0 = u.pm * 256 + wr * 64 + fr, col0 = u.pn * 256 + wc * 32 + 8 * fq;
        if (u.pn < 8) {
#pragma unroll
            for (int ai = 0; ai < 2; ++ai)
#pragma unroll
                for (int m = 0; m < 4; ++m) { bf16_t* rp = QK + (size_t)(row0 + ai * 128 + m * 16) * 2048 + col0;
#pragma unroll
                    for (int bj = 0; bj < 2; ++bj) { const f32x4 a = acc[ai][bj][m][0], b = acc[ai][bj][m][1]; u32x4 w; w.x = pk2(a[0], a[1]); w.y = pk2(a[2], a[3]); w.z = pk2(b[0], b[1]); w.w = pk2(b[2], b[3]); *(u32x4*)(rp + bj * 128) = w; } }
        } else {
            bf16_t* vb = Vt + (size_t)(col0 - 2048) * T + row0;
#pragma unroll 1
            for (int bj = 0; bj < 2; ++bj)
#pragma unroll
                for (int n = 0; n < 2; ++n)
#pragma unroll
                    for (int e = 0; e < 4; ++e) { bf16_t* cp = vb + (size_t)(bj * 128 + 4 * n + e) * T;
#pragma unroll
                        for (int ai = 0; ai < 2; ++ai)
#pragma unroll
                            for (int m = 0; m < 4; ++m) cp[ai * 128 + m * 16] = (bf16_t)f2bf(bj ? acc[ai][1][m][n][e] : acc[ai][0][m][n][e]); }
        }
    }
};
struct EpiSwiglu {
    static constexpr bool PERM = true, AFTER_DRAIN = false;
    bf16_t* O;
    __device__ __forceinline__ void operator()(const f32x4 (&acc)[2][2][4][2], const Unit& u, int wr, int wc, int fr, int fq) const {
        const int row0 = u.pm * 256 + wr * 64 + fr, col0 = u.pn * 128 + wc * 32 + 8 * fq;
#pragma unroll
        for (int ai = 0; ai < 2; ++ai)
#pragma unroll
            for (int m = 0; m < 4; ++m) { float h[8];
#pragma unroll
                for (int n = 0; n < 2; ++n)
#pragma unroll
                    for (int e = 0; e < 4; ++e) { const float a = acc[ai][0][m][n][e], b = acc[ai][1][m][n][e]; h[n * 4 + e] = a * sigm(a) * b; }
                u32x4 w; w.x = pk2(h[0], h[1]); w.y = pk2(h[2], h[3]); w.z = pk2(h[4], h[5]); w.w = pk2(h[6], h[7]);
                *(u32x4*)(O + (size_t)(row0 + ai * 128 + m * 16) * DFF + col0) = w; }
    }
};
struct EpiRes {
    static constexpr bool PERM = true, AFTER_DRAIN = false;
    const float* xlat; const float* xctx; const float* glat; const float* gctx; float* Z;
    __device__ __forceinline__ void operator()(const f32x4 (&acc)[2][2][4][2], const Unit& u, int wr, int wc, int fr, int fq) const {
        const int row0 = u.pm * 256 + wr * 64 + fr, col0 = u.pn * 256 + wc * 32 + 8 * fq;
        const bool isctx = (u.pm * 256 >= TL);
        const float* gate = isctx ? gctx : glat;
        f32x4 gv[2][2];
#pragma unroll
        for (int bj = 0; bj < 2; ++bj)
#pragma unroll
            for (int n = 0; n < 2; ++n) gv[bj][n] = *(const f32x4*)(gate + col0 + bj * 128 + 4 * n);
#pragma unroll
        for (int ai = 0; ai < 2; ++ai)
#pragma unroll
            for (int m = 0; m < 4; ++m) { const int row = row0 + ai * 128 + m * 16;
                const float* xr = isctx ? xctx + (size_t)(row - TL) * D : xlat + (size_t)row * D; float* zr = Z + (size_t)row * D;
#pragma unroll
                for (int bj = 0; bj < 2; ++bj)
#pragma unroll
                    for (int n = 0; n < 2; ++n) { const int c = col0 + bj * 128 + 4 * n; const f32x4 xv = *(const f32x4*)(xr + c); *(f32x4*)(zr + c) = xv * ALPHA + gv[bj][n] * acc[ai][bj][m][n]; } }
    }
};

struct EpiPart {
    static constexpr bool PERM = true, AFTER_DRAIN = false;
    float* P;
    __device__ __forceinline__ void operator()(const f32x4 (&acc)[2][2][4][2], const Unit& u, int wr, int wc, int fr, int fq) const {
        const int row0 = wr * 64 + fr, col0 = u.pn * 256 + wc * 32 + 8 * fq;
#pragma unroll
        for (int ai = 0; ai < 2; ++ai)
#pragma unroll
            for (int m = 0; m < 4; ++m) { float* zr = P + (size_t)(row0 + ai * 128 + m * 16) * D;
#pragma unroll
                for (int bj = 0; bj < 2; ++bj)
#pragma unroll
                    for (int n = 0; n < 2; ++n) *(f32x4*)(zr + col0 + bj * 128 + 4 * n) = acc[ai][bj][m][n]; }
    }
};
struct OneUnit { int pn;
    __device__ __forceinline__ bool next(int i, Unit& u) const { if (i != 0) return false; u.pm = 0; u.pn = pn; return true; }
    __device__ __forceinline__ void a_ready(const Unit&) const {}
    __device__ __forceinline__ void done(const Unit&) const {}
};
#define LAS __attribute__((address_space(3)))
#define XB_TMO      128
#define XB_XCNT(j)  (256  + 64 * (j))
#define XB_XSUB(j)  (1280 + 64 * (j))
#define XB_XGEN(j)  (2304 + 64 * (j))
#define XB_TOP      3328
#define XB_TOPGEN   3392
#define XCD_BAR_WORDS 3456
#define XB_SPIN_CAP (1u << 18)

__device__ __forceinline__ unsigned xb_ld(unsigned* p)              { return __hip_atomic_load(p, __ATOMIC_RELAXED, __HIP_MEMORY_SCOPE_AGENT); }
__device__ __forceinline__ unsigned xb_add(unsigned* p, unsigned v) { return __hip_atomic_fetch_add(p, v, __ATOMIC_RELAXED, __HIP_MEMORY_SCOPE_AGENT); }
__device__ __forceinline__ unsigned xb_xcc_id() { return (unsigned)__builtin_amdgcn_s_getreg((3 << 11) | 20) & 0xFu; }
#define XB_SPIN(cond, bar) do { unsigned _sp = 0; while (cond) { __builtin_amdgcn_s_sleep(1); \
    if ((++_sp & 255u) == 0u) { if (xb_ld(&(bar)[XB_TMO])) break; if (_sp > XB_SPIN_CAP) { atomicAdd(&(bar)[XB_TMO], 1u); break; } } } } while (0)

struct XcdBarrier {
    unsigned* bar; unsigned x;
    volatile LAS unsigned* st;
};

__device__ __forceinline__ XcdBarrier xcd_barrier_post(unsigned* bar, volatile LAS unsigned* st) {
    XcdBarrier b; b.bar = bar; b.x = xb_xcc_id(); b.st = st;
    if (threadIdx.x == 0) (void)xb_add(&bar[XB_XCNT(b.x)], 1u);
    return b;
}
__device__ __forceinline__ void xcd_barrier_complete(unsigned* bar, unsigned x, unsigned& nloc, unsigned& nx) {
    const unsigned G = gridDim.x * gridDim.y * gridDim.z;
    unsigned sum, cnt, mine, sp = 0u;
    for (;;) {
        sum = 0u; cnt = 0u; mine = 0u;
#pragma unroll
        for (unsigned j = 0; j < 16; ++j) { const unsigned c = xb_ld(&bar[XB_XCNT(j)]); sum += c; cnt += (c > 0u) ? 1u : 0u; mine = (j == x) ? c : mine; }
        if (sum == G) break;
        __builtin_amdgcn_s_sleep(1);
        if ((++sp & 255u) == 0u) { if (xb_ld(&bar[XB_TMO])) break; if (sp > XB_SPIN_CAP) { atomicAdd(&bar[XB_TMO], 1u); break; } }
    }
    nloc = mine > 0u ? mine : 1u; nx = cnt > 0u ? cnt : 1u;
}

__device__ __forceinline__ void xcd_barrier(const XcdBarrier& b) {
    asm volatile("s_waitcnt vmcnt(0)" ::: "memory");
    __syncthreads();
    if (threadIdx.x == 0) {
        unsigned* bar = b.bar;
        __builtin_amdgcn_s_waitcnt(0);
        unsigned nloc = b.st[0], nx = b.st[1];
        if (nloc == 0u) { xcd_barrier_complete(bar, b.x, nloc, nx); b.st[0] = nloc; b.st[1] = nx; }
        const unsigned old = xb_add(&bar[XB_XSUB(b.x)], 1u);
        const unsigned gen = old / nloc;
        if (old + 1u == (gen + 1u) * nloc) {
            __builtin_amdgcn_fence(__ATOMIC_RELEASE, "agent");
            asm volatile("s_waitcnt vmcnt(0)" ::: "memory");
            const unsigned og = xb_add(&bar[XB_TOP], 1u);
            const unsigned tg = og / nx;
            if (og + 1u == (tg + 1u) * nx) xb_add(&bar[XB_TOPGEN], 1u);
            else XB_SPIN(xb_ld(&bar[XB_TOPGEN]) == tg, bar);
            __builtin_amdgcn_fence(__ATOMIC_ACQUIRE, "agent");
            xb_add(&bar[XB_XGEN(b.x)], 1u);
            asm volatile("s_waitcnt vmcnt(0)" ::: "memory");
        } else {
            XB_SPIN(xb_ld(&bar[XB_XGEN(b.x)]) == gen, bar);
            __builtin_amdgcn_fence(__ATOMIC_ACQUIRE, "agent");
            asm volatile("s_waitcnt vmcnt(0)" ::: "memory");
        }
    }
    __syncthreads();
}

__device__ __forceinline__ void tconv_tile(const float* __restrict__ W, int K, int N, bf16_t* __restrict__ dst, int ld, int mode, int tile, float* tl) {
    const int tid = threadIdx.x, tx = tid & 63, ty = tid >> 6;
    const int nkt = K >> 6, kt = tile % nkt, nt = tile / nkt, k0 = kt * 64, n0 = nt * 64;
#pragma unroll
    for (int rr = 0; rr < 8; ++rr) { const int kk = ty * 8 + rr; tl[kk * 65 + tx] = W[(size_t)(k0 + kk) * N + n0 + tx]; }
    __syncthreads();
#pragma unroll
    for (int rr = 0; rr < 8; ++rr) { const int nn = ty * 8 + rr, n = n0 + nn; const int row = (mode == 0) ? n : ((n >> 7) * 256 + (n & 127) + (mode == 2 ? 128 : 0));
        dst[(size_t)row * ld + k0 + tx] = (bf16_t)f2bf(tl[tx * 65 + nn]); }
    __syncthreads();
}
constexpr int CJ0 = 736, CJ1 = CJ0 + 256, CJ2 = CJ1 + 704, CJ3 = CJ2 + 704, CJ4 = CJ3 + 704, CJ5 = CJ4 + 768, CJ6 = CJ5 + 256, CJ7 = CJ6 + 704, CJ8 = CJ7 + 704, CJ9 = CJ8 + 704;
__device__ __forceinline__ void conv_tile_job(const Args& a, int t, float* tl) {
    bf16_t* wb = (bf16_t*)a.out;
    if (t < CJ0) tconv_tile(a.in[11], 1024, 2944, wb + WO_WIN0 / 2, 1024, 0, t, tl);
    else if (t < CJ1) tconv_tile(a.in[25], 1024, 1024, wb + WO_WO0 / 2, 1024, 0, t - CJ0, tl);
    else if (t < CJ2) tconv_tile(a.in[8], 1024, DFF, wb + WO_WUP0 / 2, 1024, 1, t - CJ1, tl);
    else if (t < CJ3) tconv_tile(a.in[9], 1024, DFF, wb + WO_WUP0 / 2, 1024, 2, t - CJ2, tl);
    else if (t < CJ4) tconv_tile(a.in[10], DFF, 1024, wb + WO_WDN0 / 2, DFF, 0, t - CJ3, tl);
    else if (t < CJ5) tconv_tile(a.in[26], 1024, 3072, wb + WO_WIN1 / 2, 1024, 0, t - CJ4, tl);
    else if (t < CJ6) tconv_tile(a.in[28], 1024, 1024, wb + WO_WO1 / 2, 1024, 0, t - CJ5, tl);
    else if (t < CJ7) tconv_tile(a.in[8] + (size_t)D * DFF, 1024, DFF, wb + WO_WUP1 / 2, 1024, 1, t - CJ6, tl);
    else if (t < CJ8) tconv_tile(a.in[9] + (size_t)D * DFF, 1024, DFF, wb + WO_WUP1 / 2, 1024, 2, t - CJ7, tl);
    else tconv_tile(a.in[10] + (size_t)D * DFF, DFF, 1024, wb + WO_WDN1 / 2, DFF, 0, t - CJ8, tl);
}
__device__ __forceinline__ void conv_l1_tiles(const Args& a, unsigned char* lds, int t_lo, int t_hi) {
    if ((int)blockIdx.x < 240) return;
    for (int t = t_lo + ((int)blockIdx.x - 240); t < t_hi; t += (int)gridDim.x - 240) conv_tile_job(a, t, (float*)lds);
}
__device__ __forceinline__ void phase0(const Args& a, unsigned char* lds) {
    float* tl = (float*)lds; const int tid = threadIdx.x;
    bf16_t* wb = (bf16_t*)a.out;
    float* modp = (float*)(a.ws + OFF_MODP);
    constexpr int NG = 2 * 12 * KS;
    for (int it = blockIdx.x; it < NG + CJ0; it += gridDim.x) {
        if (it < NG) {
            const int layer = it / (12 * KS), cb = (it % (12 * KS)) / KS, ks = it % KS, col = cb * 512 + tid;
            if (tid < 256) { const float v = (tid < 128) ? a.in[1][ks * 128 + tid] : a.in[3][ks * 128 + tid - 128]; tl[tid] = v * sigm(v); }
            __syncthreads();
            const float* W = a.in[4] + (size_t)layer * D * 6144 + (size_t)(ks * 128) * 6144 + col;
            float a0 = 0.f, a1 = 0.f;
#pragma unroll 8
            for (int k = 0; k < 128; ++k) { const float w = W[(size_t)k * 6144]; a0 += tl[k] * w; a1 += tl[128 + k] * w; }
            if (ks == 0) { const float b = a.in[5][layer * 6144 + col]; a0 += b; a1 += b; }
            modp[((layer * 2 + 0) * KS + ks) * 6144 + col] = a0; modp[((layer * 2 + 1) * KS + ks) * 6144 + col] = a1;
            __syncthreads();
        } else conv_tile_job(a, it - NG, tl);
    }
    constexpr int E0 = 128 * 1024, E1 = E0 + 98304, E2 = E1 + 98304, E3 = E2 + 393216;
    for (int e = blockIdx.x * 512 + tid; e < E3; e += gridDim.x * 512) {
        if (e < E0) wb[WO_WIN0 / 2 + (size_t)2944 * 1024 + e] = 0;
        else if (e < E1) { const int i = e - E0, d = i / 49152, r = (i % 49152) / 64, k = i % 64; wb[WO_W2T / 2 + i] = (bf16_t)f2bf(a.in[14][(d * 64 + k) * DA + r]); }
        else if (e < E2) { const int i = e - E1, d = i / 49152, r = (i % 49152) / 64, k = i % 64; wb[WO_A2T / 2 + i] = (bf16_t)f2bf(a.in[16][(d * 64 + k) * DA + r]); }
        else { const int i = e - E2, row = i / 384, col = i % 384; float v = 0.f;
            if (row < 768) { if (col < 128) v = a.in[17][col * DA + row]; }
            else { const int g = (row - 768) >> 6, dd = (row - 768) & 63, cc = col - 128 - g * 64; if (cc >= 0 && cc < 64) v = a.in[23][(g * 64 + cc) * 64 + dd] * a.in[24][row - 768]; }
            wb[WO_BG / 2 + i] = (bf16_t)f2bf(v); }
    }
}
__device__ __forceinline__ void phase1(const Args& a, unsigned char* lds) {
    const int tid = threadIdx.x, lane = tid & 63, wave = tid >> 6;
    const float* modp = (const float*)(a.ws + OFF_MODP); float* modr = (float*)(a.ws + OFF_MODR);
    const int gid = blockIdx.x * 512 + tid;
    if (gid < 4 * 6144) { const int lv = gid / 6144, col = gid % 6144; float s = 0.f;
#pragma unroll
        for (int k = 0; k < KS; ++k) s += modp[(lv * KS + k) * 6144 + col];
        modr[gid] = s; }
    float* ml = (float*)lds;
    for (int i = tid; i < 4096; i += 512) { const int which = i >> 10, col = i & 1023, vec = which >> 1, chunk = which & 1; float s = 0.f;
#pragma unroll
        for (int k = 0; k < KS; ++k) s += modp[((0 * 2 + vec) * KS + k) * 6144 + chunk * 1024 + col];
        ml[i] = s; }
    __syncthreads();
    bf16_t* H = (bf16_t*)(a.ws + OFF_HBUF);
#pragma unroll 2
    for (int row = blockIdx.x * 8 + wave; row < T; row += gridDim.x * 8) {
        const float* src = row < TL ? a.in[0] + (size_t)row * D : a.in[2] + (size_t)(row - TL) * D; const float* mm = ml + (row < TL ? 0 : 2048);
#pragma unroll
        for (int q = 0; q < 4; ++q) { const int col = q * 256 + lane * 4; const f32x4 v = *(const f32x4*)(src + col), sh = *(const f32x4*)(mm + col), sc = *(const f32x4*)(mm + 1024 + col);
            const f32x4 h = v * (sc + 1.0f) + sh; u32x2 w; w.x = pk2(h[0], h[1]); w.y = pk2(h[2], h[3]); *(u32x2*)(H + (size_t)row * D + col) = w; }
    }
    __syncthreads();
}
__device__ __forceinline__ void ln_pass(const float* __restrict__ Z, int rows, const float* __restrict__ g, const float* __restrict__ b, float* XO,
                                        bf16_t* __restrict__ H, const float* __restrict__ modr_layer  , int sh_idx, int sc_idx,
                                        const float* part = nullptr, int nsl = 0, const float* xres_ctx = nullptr, const float* gate_ctx = nullptr) {
    const int lane = threadIdx.x & 63, wave = threadIdx.x >> 6;
#pragma unroll 2
    for (int row = blockIdx.x * 8 + wave; row < rows; row += gridDim.x * 8) {
        f32x4 v[4]; float s = 0.f;
#pragma unroll
        for (int q = 0; q < 4; ++q) { const int col = q * 256 + lane * 4;
            if (part && row >= TL) {
                f32x4 sacc = (f32x4){0.f, 0.f, 0.f, 0.f};
                for (int sl = 0; sl < nsl; ++sl) sacc += *(const f32x4*)(part + ((size_t)sl * 256 + (row - TL)) * D + col);
                v[q] = *(const f32x4*)(xres_ctx + (size_t)(row - TL) * D + col) * ALPHA + *(const f32x4*)(gate_ctx + col) * sacc;
            } else v[q] = *(const f32x4*)(Z + (size_t)row * D + col);
            s += (v[q][0] + v[q][1]) + (v[q][2] + v[q][3]); }
        const float mu = wsum(s) * (1.f / 1024.f); float qq = 0.f;
#pragma unroll
        for (int q = 0; q < 4; ++q) { const f32x4 dl = v[q] - mu; qq += (dl[0] * dl[0] + dl[1] * dl[1]) + (dl[2] * dl[2] + dl[3] * dl[3]); }
        const float rstd = rsqrtf(wsum(qq) * (1.f / 1024.f) + LN_EPS);
        const float* mv = H ? modr_layer + (row < TL ? 0 : 6144) : nullptr;
#pragma unroll
        for (int q = 0; q < 4; ++q) { const int col = q * 256 + lane * 4; const f32x4 gg = *(const f32x4*)(g + col), bb = *(const f32x4*)(b + col);
            const f32x4 xn = (v[q] - mu) * rstd * gg + bb; *(f32x4*)(XO + (size_t)row * D + col) = xn;
            if (H) { const f32x4 sh = *(const f32x4*)(mv + sh_idx * 1024 + col), sc = *(const f32x4*)(mv + sc_idx * 1024 + col); const f32x4 h = xn * (sc + 1.0f) + sh;
                u32x2 w; w.x = pk2(h[0], h[1]); w.y = pk2(h[2], h[3]); *(u32x2*)(H + (size_t)row * D + col) = w; } }
    }
}
__device__ __forceinline__ void ag_rows(const Args& a, int b0, int nb, int s_lo, int s_hi) {
    if ((int)blockIdx.x < b0 || (int)blockIdx.x >= b0 + nb) return;
    const int lane = threadIdx.x & 63, wave = threadIdx.x >> 6;
    const bf16_t* P = (const bf16_t*)(a.ws + OFF_PBUF); bf16_t* AG = (bf16_t*)(a.ws + OFF_AG);
    const float* mu = a.in[12];
    const int gc = 2560 + lane * 2; const float m00 = mu[gc], m01 = mu[gc + 1], m10 = mu[2688 + gc], m11 = mu[2688 + gc + 1];
    const int hsel = lane >> 4;
    for (int st = s_lo + ((int)blockIdx.x - b0) * 8 + wave; st < s_hi; st += nb * 8) {
        const int m0 = st * 16, s0 = m0 < TL ? 0 : TL, len = m0 < TL ? TL : TC, t0 = m0 - s0;
        const int cc = 2688 + lane * 4;
        u32x2 x[32]; unsigned gx[18];
#pragma unroll
        for (int j = 0; j < 32; ++j) { const int t = t0 - 8 + j; x[j] = (t >= 0 && t < len) ? *(const u32x2*)(P + (size_t)(s0 + t) * PLD + cc) : (u32x2){0u, 0u}; }
#pragma unroll
        for (int j = 0; j < 18; ++j) { const int t = t0 - 1 + j; gx[j] = (t >= 0 && t < len) ? *(const unsigned*)(P + (size_t)(s0 + t) * PLD + gc) : 0u; }
#pragma unroll
        for (int r = 0; r < 16; ++r) {
            const int t = t0 + r, m = m0 + r;
            { const unsigned cu = gx[r + 1], pu = gx[r], nu = gx[r + 2];
              const float c0 = bf2f(cu & 0xffff), c1 = bf2f(cu >> 16), p0 = bf2f(pu & 0xffff), p1 = bf2f(pu >> 16), n0 = bf2f(nu & 0xffff), n1 = bf2f(nu >> 16);
              const float x0 = c0 + (p0 - c0) * m00 + (n0 - c0) * m10, x1 = c1 + (p1 - c1) * m01 + (n1 - c1) * m11;
              *(unsigned*)(AG + (size_t)m * 384 + lane * 2) = pk2(sigm(x0), sigm(x1)); }
            f32x4 sw = (f32x4){0.f, 0.f, 0.f, 0.f}, acc = (f32x4){0.f, 0.f, 0.f, 0.f};
#pragma unroll
            for (int lv = 0; lv < 4; ++lv) { const int hw = 1 << lv, hp = hw >> 1;
#pragma unroll
                for (int j = -hw; j < hw; ++j) if (lv == 0 || j < -hp || j >= hp) { const u32x2 w = x[r + 8 + j]; acc += (f32x4){bf2f(w.x & 0xffff), bf2f(w.x >> 16), bf2f(w.y & 0xffff), bf2f(w.y >> 16)}; }
                if (hsel == lv) sw = acc; }
            const int half = 1 << hsel; const int lo = max(t - half, 0), hi = min(t + half, len); const float inv = rcp_((float)(hi - lo));
            const u32x2 cw = x[r + 8];
            u32x2 o; o.x = pk2(sw[0] * inv - bf2f(cw.x & 0xffff), sw[1] * inv - bf2f(cw.x >> 16)); o.y = pk2(sw[2] * inv - bf2f(cw.y & 0xffff), sw[3] * inv - bf2f(cw.y >> 16));
            *(u32x2*)(AG + (size_t)m * 384 + 128 + lane * 4) = o;
        }
    }
}
__device__ __forceinline__ void scan_pos(int d, int u, int& m, bool& hp, bool& hn) {
    if (u < TC) { const int t = d ? (TC - 1 - u) : u; m = TL + t; hp = t > 0; hn = t < TC - 1; }
    else { const int t = d ? (TL - 1 - (u - TC)) : (u - TC); m = t; hp = t > 0; hn = t < TL - 1; }
}
__device__ __forceinline__ int lane_id() { return __builtin_amdgcn_mbcnt_hi(~0u, __builtin_amdgcn_mbcnt_lo(~0u, 0u)); }
constexpr int SH_OFF = 8 * WAVE_LDS, SH_W2 = SH_OFF, SH_A2 = SH_OFF + 9216, SH_CST = SH_OFF + 18432, SH_MU = SH_CST + 1280;
__device__ __forceinline__ void scan_setup(const Args& a, int h, int d, unsigned char* lds) {
    const int tid = threadIdx.x;
    const bf16_t* wb = (const bf16_t*)a.out;
    const bf16_t* w2 = wb + WO_W2T / 2 + (size_t)(d * DA + h * 64) * 64; const bf16_t* a2 = wb + WO_A2T / 2 + (size_t)(d * DA + h * 64) * 64;
    { const int n = tid >> 3, c8 = tid & 7; *(u32x4*)(lds + SH_W2 + (n * 72 + c8 * 8) * 2) = *(const u32x4*)(w2 + n * 64 + c8 * 8); *(u32x4*)(lds + SH_A2 + (n * 72 + c8 * 8) * 2) = *(const u32x4*)(a2 + n * 64 + c8 * 8); }
    if (tid < 320) { const int which = tid >> 6, ch = tid & 63; float v;
        if (which == 0) v = a.in[13][d * DA + h * 64 + ch]; else if (which == 1) v = a.in[15][d * DA + h * 64 + ch]; else if (which == 2) v = a.in[18][h * 64 + ch]; else if (which == 3) v = a.in[19][h * 64 + ch]; else v = a.in[20][h * 64 + ch];
        ((float*)(lds + SH_CST))[which * 64 + (ch & 15) * 4 + (ch >> 4)] = v; }
    for (int i = tid; i < 640; i += 512) { const int cg = i >> 7, sel = (i >> 6) & 1, ch = i & 63;
        const int col = (cg == 0 ? h * 64 : cg == 1 ? 768 + h * 64 : cg == 2 ? 1536 + h * 64 : cg == 3 ? 2304 + d * 64 : 2432 + d * 64) + ch;
        ((float*)(lds + SH_MU))[i] = a.in[12][sel * 2688 + col]; }
    __syncthreads();
}
#define SB __builtin_amdgcn_sched_barrier(0)
struct Raw { unsigned short v[5][10]; };
#ifndef PFA
#define PFA 3
#endif
__device__ __forceinline__ void prep_geom(int d, int u0, int& mlo, int& seq_first, int& seq_last) {
    const bool isctx = u0 < TC;
    seq_first = isctx ? TL : 0; seq_last = isctx ? TL + TC - 1 : TL - 1;
    const int mu0 = isctx ? TL + (d ? TC - 1 - u0 : u0) : (d ? TL - 1 - (u0 - TC) : u0 - TC);
    mlo = d ? mu0 - 7 : mu0;
}
template <int C0, int C1>
__device__ __forceinline__ void prep_load(const bf16_t* __restrict__ P, int h, int d, int u0, Raw& raw) {
    const int lane = lane_id();
    int mlo, seq_first, seq_last; prep_geom(d, u0, mlo, seq_first, seq_last);
    const int cols[5] = {h * 64 + lane, 768 + h * 64 + lane, 1536 + h * 64 + lane, 2304 + d * 64 + lane, 2432 + d * 64 + lane};
#pragma unroll
    for (int j = 0; j < 10; ++j) { const int row = min(max(mlo - 1 + j, seq_first), seq_last); const bf16_t* rp = P + (size_t)row * PLD;
#pragma unroll
        for (int c = C0; c < C1; ++c) raw.v[c][j] = rp[cols[c]]; }
}
template <bool COEF>
__device__ __forceinline__ void scan_prep(const Raw& raw, int h, int d, int u0, float* L, bf16_t* At, const unsigned char* lds, float* coef_d) {
    const int lane = lane_id(); const int l16 = lane & 15, quad = lane >> 4;
    int mlo, seq_first, seq_last; prep_geom(d, u0, mlo, seq_first, seq_last);
    const bool okp = (mlo - 1 >= seq_first), okn = (mlo + 8 <= seq_last);
    const float* mul = (const float*)(lds + SH_MU);
#pragma unroll
    for (int c = 0; c < 5; ++c) {
        const float m0 = mul[(c * 2 + 0) * 64 + lane], m1 = mul[(c * 2 + 1) * 64 + lane];
#pragma unroll
        for (int jj = 1; jj <= 8; ++jj) {
            const int tt = d ? 8 - jj : jj - 1;
            const float cur = bf2f(raw.v[c][jj]); float pv = bf2f(raw.v[c][jj - 1]), nx = bf2f(raw.v[c][jj + 1]);
            if (jj == 1) pv = okp ? pv : 0.f;
            if (jj == 8) nx = okn ? nx : 0.f;
            const float mx = cur + (pv - cur) * m0 + (nx - cur) * m1;
            if (c == 0) L[(tt * 6 + 4) * 64 + (lane & 15) * 4 + (lane >> 4)] = mx;
            else if (c == 1) L[(tt * 6 + 2) * 64 + (lane & 15) * 4 + (lane >> 4)] = mx;
            else if (c == 2) L[(tt * 6 + 5) * 64 + lane] = mx;
            else if (c == 3) { const float e2 = __expf(2.f * mx); const bf16_t tb = (bf16_t)f2bf(1.f - 2.f * rcp_(e2 + 1.f)); At[tt * 72 + lane] = tb; At[(tt + 8) * 72 + lane] = tb; }
            else { const bf16_t ab = (bf16_t)f2bf(mx); At[16 * 72 + tt * 72 + lane] = ab; At[16 * 72 + (tt + 8) * 72 + lane] = ab; }
        }
    }
    if (lane < 8) *(int*)(At + lane * 72 + 64) = d ? mlo + 7 - lane : mlo + lane;
    wave_sync();
    f32x4 accw[4], acca[4];
#pragma unroll
    for (int nt = 0; nt < 4; ++nt) { accw[nt] = (f32x4){0.f, 0.f, 0.f, 0.f}; acca[nt] = (f32x4){0.f, 0.f, 0.f, 0.f}; }
    const bf16_t* W2l = (const bf16_t*)(lds + SH_W2); const bf16_t* A2l = (const bf16_t*)(lds + SH_A2);
#pragma unroll
    for (int ks = 0; ks < 2; ++ks) {
        const bf16x8 aw = *(const bf16x8*)(At + l16 * 72 + ks * 32 + quad * 8), aa = *(const bf16x8*)(At + 16 * 72 + l16 * 72 + ks * 32 + quad * 8);
#pragma unroll
        for (int nt = 0; nt < 4; ++nt) {
            const bf16x8 bw = *(const bf16x8*)(W2l + (nt * 16 + l16) * 72 + ks * 32 + quad * 8), ba = *(const bf16x8*)(A2l + (nt * 16 + l16) * 72 + ks * 32 + quad * 8);
            accw[nt] = __builtin_amdgcn_mfma_f32_16x16x32_bf16(aw, bw, accw[nt], 0, 0, 0); acca[nt] = __builtin_amdgcn_mfma_f32_16x16x32_bf16(aa, ba, acca[nt], 0, 0, 0);
        }
    }
    const float* cst = (const float*)(lds + SH_CST);
    const bool hi = quad >= 2; const int ntb = hi ? 2 : 0;
    f32x4 aw[2], aa[2];
    aw[0] = hi ? accw[2] : accw[0]; aw[1] = hi ? accw[3] : accw[1]; aa[0] = hi ? acca[2] : acca[0]; aa[1] = hi ? acca[3] : acca[1];
#pragma unroll
    for (int j = 0; j < 4; ++j) {
        SB;
        const int o2 = l16 * 4 + ntb;
        const f32x2 cw0 = *(const f32x2*)(cst + o2), ca0 = *(const f32x2*)(cst + 64 + o2), ckk = *(const f32x2*)(cst + 128 + o2), cka = *(const f32x2*)(cst + 192 + o2), crk = *(const f32x2*)(cst + 256 + o2);
        const int tok = (quad & 1) * 4 + j;
        const f32x2 kv = *(const f32x2*)(L + (tok * 6 + 2) * 64 + o2), rv = *(const f32x2*)(L + (tok * 6 + 4) * 64 + o2);
        const f32x2 kkv = kv * ckk;
        float ss = xsum32(sum16(kkv[0] * kkv[0] + kkv[1] * kkv[1]));
        const float inv = __builtin_amdgcn_rsqf(fmaxf(ss, 1e-24f));
        float cs = 0.f; f32x2 o_w, o_b, o_kd, o_kk;
#pragma unroll
        for (int e = 0; e < 2; ++e) {
            o_w[e] = __expf(-0.60653066f * sigm(cw0[e] + aw[e][j]));
            const float av = sigm(ca0[e] + aa[e][j]);
            o_kk[e] = kkv[e] * inv; o_b[e] = o_kk[e] * av; o_kd[e] = kv[e] * (1.f + (av - 1.f) * cka[e]);
            if (COEF) cs += rv[e] * o_kd[e] * crk[e];
        }
        { const int n0 = ntb * 16 + l16;
          L[(tok * 6 + 0) * 64 + n0] = o_w[0]; L[(tok * 6 + 0) * 64 + n0 + 16] = o_w[1]; L[(tok * 6 + 1) * 64 + n0] = o_b[0]; L[(tok * 6 + 1) * 64 + n0 + 16] = o_b[1];
          L[(tok * 6 + 2) * 64 + n0] = o_kd[0]; L[(tok * 6 + 2) * 64 + n0 + 16] = o_kd[1]; }
        *(f32x2*)(L + (tok * 6 + 3) * 64 + o2) = o_kk;
        if (COEF) { cs = xsum32(sum16(cs)); if (lane < 32 && l16 == 0) { const int m = *(const int*)(At + tok * 72 + 64); coef_d[(size_t)m * 12 + h] = cs; } }
    }
    wave_sync();
}
#define FMAC_K(acc, X, Sv, K) asm volatile("v_fmac_f32_dpp %0, %1, %2 row_newbcast:" #K " row_mask:0xf bank_mask:0xf" : "+v"(acc) : "v"(X), "v"(Sv))
#define MULIP_K(Sv, X, K) asm volatile("v_mul_f32_dpp %0, %1, %0 row_newbcast:" #K " row_mask:0xf bank_mask:0xf" : "+v"(Sv) : "v"(X))
#define K16(M) M(0) M(1) M(2) M(3) M(4) M(5) M(6) M(7) M(8) M(9) M(10) M(11) M(12) M(13) M(14) M(15)
#ifndef DEPC_
#define DEPC_ 3
#endif
#ifndef DEPA_
#define DEPA_ 2
#endif
struct TokVec { f32x4 kk, r; float v; };
__device__ __forceinline__ void tok_load(TokVec& t, const float* V, int lane_unused, bool need_r) {
    const int lane = lane_id(); const int o = (lane & 15) * 4;
    t.kk = *(const f32x4*)(V + 192 + o);
    if (need_r) t.r = *(const f32x4*)(V + 256 + o);
    t.v = V[320 + lane];
}
#define F2(v, i) ((f32x2){(v)[2 * (i)], (v)[2 * (i) + 1]})
#define SPn(n) SP[(n) >> 1][(n) & 1]
#define SQn(n) SQ[(n) >> 1][(n) & 1]
#define SSn(n) S[(n) >> 1][(n) & 1]
#define A_DOT(k) FMAC_K(ap0, kk0, SPn(k), k); FMAC_K(ap1, kk1, SPn(16 + k), k); FMAC_K(ap2, kk2, SPn(32 + k), k); FMAC_K(ap3, kk3, SPn(48 + k), k); \
                 FMAC_K(aq0, kk0, SQn(k), k); FMAC_K(aq1, kk1, SQn(16 + k), k); FMAC_K(aq2, kk2, SQn(32 + k), k); FMAC_K(aq3, kk3, SQn(48 + k), k);
__device__ __forceinline__ void scan_passA(const Args& a, unsigned char* lds) {
    const int lane = threadIdx.x & 63, wave = __builtin_amdgcn_readfirstlane(threadIdx.x >> 6);
    if ((int)blockIdx.x * 8 >= 24 * NC) return;
    const int item = blockIdx.x * 8 + wave, hd = (blockIdx.x * 8) / NC, cidx = item % NC, h = hd >> 1, d = hd & 1;
    scan_setup(a, h, d, lds);
    float* L = (float*)(lds + wave * WAVE_LDS); bf16_t* At = (bf16_t*)(lds + wave * WAVE_LDS + NS * 6 * 64 * 4);
    const bf16_t* P = (const bf16_t*)(a.ws + OFF_PBUF);
    f32x2 SP[32], SQ[32];
#pragma unroll
    for (int q = 0; q < 32; ++q) { SP[q] = (f32x2){(2 * q == lane) ? 1.f : 0.f, (2 * q + 1 == lane) ? 1.f : 0.f}; SQ[q] = (f32x2){0.f, 0.f}; }
    Raw raw; prep_load<0, PFA>(P, h, d, cidx * CH, raw);
#pragma unroll 1
    for (int g = 0; g < CH / NS; ++g) {
        prep_load<PFA, 5>(P, h, d, cidx * CH + g * NS, raw);
        scan_prep<false>(raw, h, d, cidx * CH + g * NS, L, At, lds, nullptr);
        prep_load<0, PFA>(P, h, d, cidx * CH + min(g + 1, CH / NS - 1) * NS, raw);
#pragma unroll 1
        for (int tt = 0; tt < NS; ++tt) {
            const float* V = L + tt * 384;
            TokVec TA; tok_load(TA, V, lane, false);
            constexpr int DEPA = DEPA_;
            f32x4 ub[DEPA + 1][3];
#define A_ISSUE(qi) { ub[(qi) % (DEPA + 1)][0] = *(const f32x4*)(V + (qi) * 4); ub[(qi) % (DEPA + 1)][1] = *(const f32x4*)(V + 64 + (qi) * 4); ub[(qi) % (DEPA + 1)][2] = *(const f32x4*)(V + 128 + (qi) * 4); }
#pragma unroll
            for (int qi = 0; qi < DEPA; ++qi) A_ISSUE(qi)
            SB;
            const float kk0 = TA.kk[0], kk1 = TA.kk[1], kk2 = TA.kk[2], kk3 = TA.kk[3], vv = TA.v;
            float ap0 = 0.f, ap1 = 0.f, ap2 = 0.f, ap3 = 0.f, aq0 = 0.f, aq1 = 0.f, aq2 = 0.f, aq3 = 0.f;
            K16(A_DOT)
            const float sap = -((ap0 + ap1) + (ap2 + ap3)), saq = -((aq0 + aq1) + (aq2 + aq3));
            const f32x2 sap2 = (f32x2){sap, sap}, saq2 = (f32x2){saq, saq}, v2 = (f32x2){vv, vv};
#pragma unroll
            for (int q = 0; q < 16; ++q) {
                if (q + DEPA < 16) A_ISSUE(q + DEPA)
                SB;
                { const f32x4 w4 = ub[q % (DEPA + 1)][0], b4 = ub[q % (DEPA + 1)][1], d4 = ub[q % (DEPA + 1)][2];
                    SP[2 * q] = SP[2 * q] * F2(w4, 0) + sap2 * F2(b4, 0); SP[2 * q + 1] = SP[2 * q + 1] * F2(w4, 1) + sap2 * F2(b4, 1);
                    SQ[2 * q] = SQ[2 * q] * F2(w4, 0) + (saq2 * F2(b4, 0) + v2 * F2(d4, 0)); SQ[2 * q + 1] = SQ[2 * q + 1] * F2(w4, 1) + (saq2 * F2(b4, 1) + v2 * F2(d4, 1)); }
                SB;
            }
        }
        wave_sync();
    }
    float* PQ = (float*)(a.ws + OFF_PQ) + (size_t)item * 8192; const int lane2 = lane_id();
#pragma unroll
    for (int q = 0; q < 16; ++q) { *(f32x4*)(PQ + lane2 * 64 + q * 4) = (f32x4){SP[2 * q][0], SP[2 * q][1], SP[2 * q + 1][0], SP[2 * q + 1][1]};
        *(f32x4*)(PQ + 4096 + lane2 * 64 + q * 4) = (f32x4){SQ[2 * q][0], SQ[2 * q][1], SQ[2 * q + 1][0], SQ[2 * q + 1][1]}; }
}
__device__ __forceinline__ void scan_passB(const Args& a, unsigned char* lds) {
    const int tid = threadIdx.x, b = blockIdx.x, hd = (b & 7) * 3 + (b >> 6), rg = (b >> 3) & 7, il = tid >> 6, n = tid & 63, i = rg * 8 + il;
    float* Sl = (float*)lds;
    float* Pl = Sl + 1024;
    float* base = (float*)(a.ws + OFF_PQ) + (size_t)hd * NC * 8192;
    Sl[tid] = 0.f;
    f32x4 p0 = *(const f32x4*)(base + tid * 8), p1 = *(const f32x4*)(base + tid * 8 + 4);
    *(f32x4*)(Pl + tid * 8) = p0; *(f32x4*)(Pl + tid * 8 + 4) = p1;
    float q = base[4096 + i * 64 + n], qn = 0.f;
    if (NC > 2) { p0 = *(const f32x4*)(base + 8192 + tid * 8); p1 = *(const f32x4*)(base + 8192 + tid * 8 + 4); qn = base[8192 + 4096 + i * 64 + n]; }
    __syncthreads();
    for (int c = 0; c < NC - 1; ++c) {
        const int cur = c & 1;
        const float* Sc = Sl + cur * 512 + il * 64; const float* Pc = Pl + cur * 4096 + n;
        float acc0 = q, acc1 = 0.f;
#pragma unroll
        for (int m = 0; m < 64; m += 4) { const f32x4 s4 = *(const f32x4*)(Sc + m);
            acc0 += s4[0] * Pc[(m + 0) * 64]; acc1 += s4[1] * Pc[(m + 1) * 64]; acc0 += s4[2] * Pc[(m + 2) * 64]; acc1 += s4[3] * Pc[(m + 3) * 64]; }
        const float acc = acc0 + acc1;
        Sl[(cur ^ 1) * 512 + il * 64 + n] = acc; base[(size_t)c * 8192 + 4096 + i * 64 + n] = acc;
        *(f32x4*)(Pl + (cur ^ 1) * 4096 + tid * 8) = p0; *(f32x4*)(Pl + (cur ^ 1) * 4096 + tid * 8 + 4) = p1; q = qn;
        if (c + 2 < NC - 1) { const float* nb = base + (size_t)(c + 2) * 8192; p0 = *(const f32x4*)(nb + tid * 8); p1 = *(const f32x4*)(nb + tid * 8 + 4); qn = nb[4096 + i * 64 + n]; }
        __syncthreads();
    }
}
#define C_DOT(k) FMAC_K(aq0, kk0, SSn(k), k); FMAC_K(aq1, kk1, SSn(16 + k), k); FMAC_K(aq2, kk2, SSn(32 + k), k); FMAC_K(aq3, kk3, SSn(48 + k), k);
#define C_Y(k) FMAC_K(ya0, r0, SSn(k), k); FMAC_K(ya1, r1, SSn(16 + k), k); FMAC_K(ya2, r2, SSn(32 + k), k); FMAC_K(ya3, r3, SSn(48 + k), k);
__device__ __forceinline__ void scan_passC(const Args& a, unsigned char* lds) {
    const int lane = threadIdx.x & 63, wave = __builtin_amdgcn_readfirstlane(threadIdx.x >> 6);
    if ((int)blockIdx.x * 8 >= 24 * NC) return;
    const int item = blockIdx.x * 8 + wave, hd = (blockIdx.x * 8) / NC, cidx = item % NC, h = hd >> 1, d = hd & 1;
    scan_setup(a, h, d, lds);
    float* L = (float*)(lds + wave * WAVE_LDS); bf16_t* At = (bf16_t*)(lds + wave * WAVE_LDS + NS * 6 * 64 * 4);
    const bf16_t* P = (const bf16_t*)(a.ws + OFF_PBUF);
    bf16_t* Y = (bf16_t*)(a.ws + OFF_Y) + (size_t)d * T * DA; float* coef_d = (float*)(a.ws + OFF_COEF) + (size_t)d * T * 12;
    f32x2 S[32];
    if (cidx > 0) { const float* S0 = (const float*)(a.ws + OFF_PQ) + (size_t)(item - 1) * 8192 + 4096 + lane * 64;
#pragma unroll
        for (int q = 0; q < 16; ++q) { const f32x4 s4 = *(const f32x4*)(S0 + q * 4); S[2 * q] = (f32x2){s4[0], s4[1]}; S[2 * q + 1] = (f32x2){s4[2], s4[3]}; } }
    else {
#pragma unroll
        for (int q = 0; q < 32; ++q) S[q] = (f32x2){0.f, 0.f}; }
#pragma unroll 1
    for (int g = 0; g < CH / NS; ++g) {
        const int u0 = cidx * CH + g * NS;
        { Raw raw; prep_load<0, 5>(P, h, d, u0, raw); scan_prep<true>(raw, h, d, u0, L, At, lds, coef_d); }
#pragma unroll 1
        for (int tt = 0; tt < NS; ++tt) {
            const float* V = L + tt * 384;
            TokVec TA; tok_load(TA, V, lane, true);
            const int m0 = *(const int*)(At + tt * 72 + 64);
            constexpr int DEP = DEPC_;
            f32x4 ub[DEP + 1][2][3];
#define C_ISSUE(bb) { _Pragma("unroll") for (int qq = 0; qq < 2; ++qq) { const int q_ = (bb) * 2 + qq; ub[(bb) % (DEP + 1)][qq][0] = *(const f32x4*)(V + q_ * 4); ub[(bb) % (DEP + 1)][qq][1] = *(const f32x4*)(V + 64 + q_ * 4); ub[(bb) % (DEP + 1)][qq][2] = *(const f32x4*)(V + 128 + q_ * 4); } }
#pragma unroll
            for (int bb = 0; bb < DEP; ++bb) C_ISSUE(bb)
            SB;
            const float kk0 = TA.kk[0], kk1 = TA.kk[1], kk2 = TA.kk[2], kk3 = TA.kk[3], r0 = TA.r[0], r1 = TA.r[1], r2 = TA.r[2], r3 = TA.r[3], vv = TA.v;
            float aq0 = 0.f, aq1 = 0.f, aq2 = 0.f, aq3 = 0.f;
            K16(C_DOT)
            const float sa = -((aq0 + aq1) + (aq2 + aq3));
            const f32x2 sa2 = (f32x2){sa, sa}, v2 = (f32x2){vv, vv};
#pragma unroll
            for (int b = 0; b < 8; ++b) {
                if (b + DEP < 8) C_ISSUE(b + DEP)
                SB;
#pragma unroll
                for (int qq = 0; qq < 2; ++qq) { const int q = b * 2 + qq; const f32x4 w4 = ub[b % (DEP + 1)][qq][0], b4 = ub[b % (DEP + 1)][qq][1], d4 = ub[b % (DEP + 1)][qq][2];
                    S[2 * q] = S[2 * q] * F2(w4, 0) + (sa2 * F2(b4, 0) + v2 * F2(d4, 0)); S[2 * q + 1] = S[2 * q + 1] * F2(w4, 1) + (sa2 * F2(b4, 1) + v2 * F2(d4, 1)); }
                SB;
            }
            float ya0 = 0.f, ya1 = 0.f, ya2 = 0.f, ya3 = 0.f;
            K16(C_Y)
            { const int ln = lane_id(); Y[(size_t)m0 * DA + h * 64 + ln] = (bf16_t)f2bf((ya0 + ya1) + (ya2 + ya3)); }
        }
        wave_sync();
    }
}
__device__ __forceinline__ void readout_rows(const Args& a) {
    const int lane = threadIdx.x & 63, wave = threadIdx.x >> 6, hg = lane >> 4, sub = lane & 15;
    const bf16_t* P = (const bf16_t*)(a.ws + OFF_PBUF); const bf16_t* Y = (const bf16_t*)(a.ws + OFF_Y); const float* CO = (const float*)(a.ws + OFF_COEF);
    bf16_t* H = (bf16_t*)(a.ws + OFF_HBUF);
#pragma unroll 2
    for (int m = blockIdx.x * 8 + wave; m < T; m += gridDim.x * 8) {
        const int s0 = m < TL ? 0 : TL, len = m < TL ? TL : TC, t = m - s0; const bool hp = t > 0, hn = t < len - 1;
        const bf16_t* row = P + (size_t)m * PLD;
#pragma unroll
        for (int hq = 0; hq < 3; ++hq) {
            const int h = hq * 4 + hg, ch = h * 64 + sub * 4, vc = 1536 + ch;
            const u32x2 y0 = *(const u32x2*)(Y + (size_t)m * DA + ch), y1 = *(const u32x2*)(Y + (size_t)(T + m) * DA + ch);
            const u32x2 pc = *(const u32x2*)(row + vc); const u32x2 pp = hp ? *(const u32x2*)(row + vc - PLD) : (u32x2){0u, 0u}; const u32x2 pn = hn ? *(const u32x2*)(row + vc + PLD) : (u32x2){0u, 0u};
            const u32x2 gw = *(const u32x2*)(H + (size_t)m * D + ch);
            const f32x4 lg = *(const f32x4*)(a.in[21] + ch), lb = *(const f32x4*)(a.in[22] + ch), m0 = *(const f32x4*)(a.in[12] + vc), m1 = *(const f32x4*)(a.in[12] + 2688 + vc);
            const float coef = CO[(size_t)m * 12 + h] + CO[(size_t)(T + m) * 12 + h];
            float y[4] = {bf2f(y0.x & 0xffff) + bf2f(y1.x & 0xffff), bf2f(y0.x >> 16) + bf2f(y1.x >> 16), bf2f(y0.y & 0xffff) + bf2f(y1.y & 0xffff), bf2f(y0.y >> 16) + bf2f(y1.y >> 16)};
            const float cu[4] = {bf2f(pc.x & 0xffff), bf2f(pc.x >> 16), bf2f(pc.y & 0xffff), bf2f(pc.y >> 16)};
            const float pv[4] = {bf2f(pp.x & 0xffff), bf2f(pp.x >> 16), bf2f(pp.y & 0xffff), bf2f(pp.y >> 16)};
            const float nx[4] = {bf2f(pn.x & 0xffff), bf2f(pn.x >> 16), bf2f(pn.y & 0xffff), bf2f(pn.y >> 16)};
            const float g[4] = {bf2f(gw.x & 0xffff), bf2f(gw.x >> 16), bf2f(gw.y & 0xffff), bf2f(gw.y >> 16)};
            const float mu = sum16((y[0] + y[1]) + (y[2] + y[3])) * (1.f / 64.f);
            float q = 0.f;
#pragma unroll
            for (int e = 0; e < 4; ++e) { y[e] -= mu; q += y[e] * y[e]; }
            const float rstd = rsqrtf(sum16(q) * (1.f / 64.f) + GN_EPS);
            float o[4];
#pragma unroll
            for (int e = 0; e < 4; ++e) { const float v = cu[e] + (pv[e] - cu[e]) * m0[e] + (nx[e] - cu[e]) * m1[e]; o[e] = (y[e] * rstd * lg[e] + lb[e] + coef * v) * g[e]; }
            u32x2 w; w.x = pk2(o[0], o[1]); w.y = pk2(o[2], o[3]);
            *(u32x2*)(H + (size_t)m * D + ch) = w;
        }
    }
}
constexpr int NA_KC = 0, NA_VC = 36864, NA_RPB = 36864 + 33792;
template <int HALF, int KSTRIDE, int VSTRIDE>
__device__ __forceinline__ void natten_half(const bf16_t* __restrict__ kbase, const bf16_t* __restrict__ vbase, const float* __restrict__ rpbh, const bf16x8 q0, const bf16x8 q1,
                                            int quad, int kr0, int kc0, int sc, f32x4 (&o)[4], float& mrun, float& lrun) {
#define KOFF(kt) (HALF ? (kt) * 16 : (((kt) >> 1) * 64 + ((kt) & 1) * 16))
    f32x4 s[16];
    {
        bf16x8 kf[16][2];
        const bf16_t* kp = kbase;
#pragma unroll
        for (int kt = 0; kt < 16; ++kt) { kf[kt][0] = *(const bf16x8*)kp; kf[kt][1] = *(const bf16x8*)(kp + 32); kp += (size_t)(KOFF(kt + 1) - KOFF(kt)) * KSTRIDE; }
        SB;
#pragma unroll
        for (int kt = 0; kt < 16; ++kt) { f32x4 z = (f32x4){0.f, 0.f, 0.f, 0.f};
            z = __builtin_amdgcn_mfma_f32_16x16x32_bf16(kf[kt][0], q0, z, 0, 0, 0); s[kt] = __builtin_amdgcn_mfma_f32_16x16x32_bf16(kf[kt][1], q1, z, 0, 0, 0); }
        SB;
    }
    u32x2 vf[8][4][2];
#pragma unroll
    for (int kp2 = 0; kp2 < 8; ++kp2)
#pragma unroll
        for (int dt = 0; dt < 4; ++dt) { const bf16_t* vp = vbase + (size_t)dt * 16 * VSTRIDE; vf[kp2][dt][0] = *(const u32x2*)(vp + KOFF(2 * kp2)); vf[kp2][dt][1] = *(const u32x2*)(vp + KOFF(2 * kp2 + 1)); }
    SB;
    float mx = -1e30f;
#pragma unroll
    for (int kt = 0; kt < 16; ++kt)
#pragma unroll
        for (int j = 0; j < 4; ++j) {
            float v = s[kt][j] * 0.125f;
            if (HALF == 0) { const int kc = kc0 + (kt & 1) * 16 + j; const bool ok = (kc >= sc) && (kc < sc + 16);
                if (ok) v += rpbh[(kr0 + (kt >> 1)) * 31 + kc]; else v = -1e30f; }
            s[kt][j] = v; mx = fmaxf(mx, v);
        }
    mx = fmaxf(mx, __shfl_xor(mx, 16)); mx = fmaxf(mx, __shfl_xor(mx, 32));
    const float mnew = fmaxf(mrun, mx), resc = __expf(mrun - mnew);
    float sm = 0.f;
#pragma unroll
    for (int kt = 0; kt < 16; ++kt)
#pragma unroll
        for (int j = 0; j < 4; ++j) { const float e = __expf(s[kt][j] - mnew); s[kt][j] = e; sm += e; }
    sm += __shfl_xor(sm, 16); sm += __shfl_xor(sm, 32);
    lrun = lrun * resc + sm; mrun = mnew;
#pragma unroll
    for (int j = 0; j < 4; ++j) { const float rj = __shfl(resc, quad * 4 + j);
#pragma unroll
        for (int dt = 0; dt < 4; ++dt) o[dt][j] *= rj; }
    SB;
#pragma unroll
    for (int kp2 = 0; kp2 < 8; ++kp2) {
        const int ka = 2 * kp2, kb = 2 * kp2 + 1;
        u32x4 pw; pw.x = pk2(s[ka][0], s[ka][1]); pw.y = pk2(s[ka][2], s[ka][3]); pw.z = pk2(s[kb][0], s[kb][1]); pw.w = pk2(s[kb][2], s[kb][3]);
        const bf16x8 pa = __builtin_bit_cast(bf16x8, pw);
#pragma unroll
        for (int dt = 0; dt < 4; ++dt) {
            u32x4 vw; vw.x = vf[kp2][dt][0].x; vw.y = vf[kp2][dt][0].y; vw.z = vf[kp2][dt][1].x; vw.w = vf[kp2][dt][1].y;
            o[dt] = __builtin_amdgcn_mfma_f32_16x16x32_bf16(pa, __builtin_bit_cast(bf16x8, vw), o[dt], 0, 0, 0);
        }
    }
    SB;
#undef KOFF
}
#define NA_BLOCK(t, BIAS) { \
    f32x4 sA = (f32x4){0.f, 0.f, 0.f, 0.f}, sB = (f32x4){0.f, 0.f, 0.f, 0.f}; \
    sA = __builtin_amdgcn_mfma_f32_16x16x32_bf16(kA0, qa[t], sA, 0, 0, 0); sA = __builtin_amdgcn_mfma_f32_16x16x32_bf16(kA1, qb[t], sA, 0, 0, 0); \
    sB = __builtin_amdgcn_mfma_f32_16x16x32_bf16(kB0, qa[t], sB, 0, 0, 0); sB = __builtin_amdgcn_mfma_f32_16x16x32_bf16(kB1, qb[t], sB, 0, 0, 0); \
    float v_[8]; \
    _Pragma("unroll") for (int j = 0; j < 4; ++j) { v_[j] = sA[j] * 0.125f; v_[4 + j] = sB[j] * 0.125f; } \
    if (BIAS) { const float* rb_ = rpbl + (kr - (r0 + t) + 7) * 31 + (15 - cq); \
        _Pragma("unroll") for (int j = 0; j < 4; ++j) { const int kcA = cbase + quad * 4 + j, kcB = kcA + 16; \
            v_[j] = (kcA >= sc && kcA < sc + 16) ? v_[j] + rb_[kcA] : -1e30f; v_[4 + j] = (kcB >= sc && kcB < sc + 16) ? v_[4 + j] + rb_[kcB] : -1e30f; } } \
    float bm_ = fmaxf(fmaxf(fmaxf(v_[0], v_[1]), fmaxf(v_[2], v_[3])), fmaxf(fmaxf(v_[4], v_[5]), fmaxf(v_[6], v_[7]))); \
    if (__any(bm_ > mref[t] + 8.f)) { bm_ = xmax32(xmax16(bm_));     \
        const bool need_ = bm_ > mref[t] + 8.f; const float mn_ = need_ ? bm_ : mref[t]; const float rs_ = __expf(mref[t] - mn_); lsum[t] *= rs_; mref[t] = mn_; \
        _Pragma("unroll") for (int j = 0; j < 4; ++j) { const float rj_ = __shfl(rs_, quad * 4 + j); \
            _Pragma("unroll") for (int dt = 0; dt < 4; ++dt) o[t][dt][j] *= rj_; } } \
    float ps_ = 0.f; \
    _Pragma("unroll") for (int i = 0; i < 8; ++i) { v_[i] = __expf(v_[i] - mref[t]); ps_ += v_[i]; } \
    lsum[t] += ps_;     \
    u32x4 pw_; pw_.x = pk2(v_[0], v_[1]); pw_.y = pk2(v_[2], v_[3]); pw_.z = pk2(v_[4], v_[5]); pw_.w = pk2(v_[6], v_[7]); \
    const bf16x8 pa_ = __builtin_bit_cast(bf16x8, pw_); \
    _Pragma("unroll") for (int dt = 0; dt < 4; ++dt) o[t][dt] = __builtin_amdgcn_mfma_f32_16x16x32_bf16(pa_, vfr[dt], o[t][dt], 0, 0, 0); }
__device__ __forceinline__ void natten(const Args& a, unsigned char* lds) {
    const int tid = threadIdx.x, lane = tid & 63, wave = __builtin_amdgcn_readfirstlane(tid >> 6), l16 = lane & 15, quad = lane >> 4;
    const bf16_t* QK = (const bf16_t*)(a.ws + OFF_QK); const bf16_t* Vt = (const bf16_t*)(a.ws + OFF_VT); bf16_t* O = (bf16_t*)(a.ws + OFF_HBUF);
    const int h = blockIdx.x & 15, rb = blockIdx.x >> 4;
    bf16_t* Kc = (bf16_t*)(lds + NA_KC); bf16_t* Vc = (bf16_t*)(lds + NA_VC); float* rpbl = (float*)(lds + NA_RPB);
    for (int i = tid; i < 2048; i += 512) { const int t = i >> 3, c8 = i & 7; *(u32x4*)(Kc + t * 72 + c8 * 8) = *(const u32x4*)(QK + (size_t)(TL + t) * 2048 + 1024 + h * 64 + c8 * 8);
        const int dd = i >> 5, c32 = i & 31; *(u32x4*)(Vc + dd * 264 + c32 * 8) = *(const u32x4*)(Vt + (size_t)(h * 64 + dd) * T + TL + c32 * 8); }
    if (tid < 465) rpbl[tid] = a.in[27][h * 465 + tid];
    __syncthreads();
#pragma unroll 1
    for (int jt = wave; jt < 16; jt += 8) {
        const int cgi = jt & 3, r0 = (rb * 4 + (jt >> 2)) * 4, c0 = cgi * 16, cbase = min(max(c0 - 8, 0), 32);
        const int cq = c0 + l16, sc = min(max(cq - 8, 0), 48);
        bf16x8 qa[4], qb[4];
#pragma unroll
        for (int t = 0; t < 4; ++t) { const bf16_t* qp = QK + (size_t)((r0 + t) * 64 + c0 + l16) * 2048 + h * 64 + quad * 8; qa[t] = *(const bf16x8*)qp; qb[t] = *(const bf16x8*)(qp + 32); }
        f32x4 o[4][4]; float mref[4], lsum[4];
#pragma unroll
        for (int t = 0; t < 4; ++t) { mref[t] = -1e30f; lsum[t] = 0.f;
#pragma unroll
            for (int dt = 0; dt < 4; ++dt) o[t][dt] = (f32x4){0.f, 0.f, 0.f, 0.f}; }
        const int krlo = min(max(r0 - 4, 0), 248), krhi = min(max(r0 + 3 - 4, 0), 248) + 7;
        bf16x8 nA0, nA1, nB0, nB1; u32x2 nva[4], nvb[4];
#define NA_LOADKV(krx) { const int tk_ = (krx) * 64 + cbase; const bf16_t* kp_ = QK + (size_t)(tk_ + l16) * 2048 + 1024 + h * 64 + quad * 8; \
            nA0 = *(const bf16x8*)kp_; nA1 = *(const bf16x8*)(kp_ + 32); nB0 = *(const bf16x8*)(kp_ + 16 * 2048); nB1 = *(const bf16x8*)(kp_ + 16 * 2048 + 32); \
            _Pragma("unroll") for (int dt = 0; dt < 4; ++dt) { const bf16_t* vp_ = Vt + (size_t)(h * 64 + dt * 16 + l16) * T + tk_ + quad * 4; nva[dt] = *(const u32x2*)vp_; nvb[dt] = *(const u32x2*)(vp_ + 16); } }
        NA_LOADKV(krlo)
#pragma unroll 1
        for (int kr = krlo; kr <= krhi; ++kr) {
            const bf16x8 kA0 = nA0, kA1 = nA1, kB0 = nB0, kB1 = nB1;
            bf16x8 vfr[4];
#pragma unroll
            for (int dt = 0; dt < 4; ++dt) { u32x4 vw; vw.x = nva[dt].x; vw.y = nva[dt].y; vw.z = nvb[dt].x; vw.w = nvb[dt].y; vfr[dt] = __builtin_bit_cast(bf16x8, vw); }
            NA_LOADKV(min(kr + 1, krhi))
            SB;
#pragma unroll
            for (int t = 0; t < 4; ++t) { const int srt = min(max(r0 + t - 4, 0), 248); if (kr >= srt && kr <= srt + 7) NA_BLOCK(t, true) }
        }
#define NA_LOADC(kbx) { const bf16_t* kp_ = Kc + ((kbx) * 32 + l16) * 72 + quad * 8; \
            nA0 = *(const bf16x8*)kp_; nA1 = *(const bf16x8*)(kp_ + 32); nB0 = *(const bf16x8*)(kp_ + 16 * 72); nB1 = *(const bf16x8*)(kp_ + 16 * 72 + 32); \
            _Pragma("unroll") for (int dt = 0; dt < 4; ++dt) { const bf16_t* vp_ = Vc + (dt * 16 + l16) * 264 + (kbx) * 32 + quad * 4; nva[dt] = *(const u32x2*)vp_; nvb[dt] = *(const u32x2*)(vp_ + 16); } }
        NA_LOADC(0)
#pragma unroll 1
        for (int kb = 0; kb < 8; ++kb) {
            const int kr = 0; (void)kr;
            const bf16x8 kA0 = nA0, kA1 = nA1, kB0 = nB0, kB1 = nB1;
            bf16x8 vfr[4];
#pragma unroll
            for (int dt = 0; dt < 4; ++dt) { u32x4 vw; vw.x = nva[dt].x; vw.y = nva[dt].y; vw.z = nvb[dt].x; vw.w = nvb[dt].y; vfr[dt] = __builtin_bit_cast(bf16x8, vw); }
            NA_LOADC(min(kb + 1, 7))
            SB;
#pragma unroll
            for (int t = 0; t < 4; ++t) NA_BLOCK(t, false)
        }
#pragma unroll
        for (int t = 0; t < 4; ++t)
#pragma unroll
            for (int j = 0; j < 4; ++j) { const float lt_ = xsum32(xsum16(lsum[t])); const float inv = 1.f / __shfl(lt_, quad * 4 + j);
#pragma unroll
                for (int dt = 0; dt < 4; ++dt) O[(size_t)((r0 + t) * 64 + c0 + quad * 4 + j) * D + h * 64 + dt * 16 + l16] = (bf16_t)f2bf(o[t][dt][j] * inv); }
    }
    __syncthreads();
}
template <class Epi>
__device__ __forceinline__ void run_gemm(unsigned char* lds, const bf16_t* A, const bf16_t* Bt, int M, int N, int K, int G, int c, const Epi& E) {
    pg8::Gemm g{A, Bt, M, N, K, K}; pg8::StaticOrder S; S.init(M, N, G, c);
    pg8::gemm_phase<Epi, pg8::StaticOrder, true, true>((PG8_LAS unsigned char*)lds, g, S, E);
}
template <class Epi>
__device__ __forceinline__ void run_slice(unsigned char* lds, const bf16_t* A, const bf16_t* Bt, int ld, int pn, const Epi& E) {
    pg8::Gemm g{A, Bt, 256, 1024, 256, ld}; OneUnit S{pn};
    pg8::gemm_phase<Epi, OneUnit, true, true>((PG8_LAS unsigned char*)lds, g, S, E);
}
__global__ void __launch_bounds__(512) mega(Args a) {
    extern __shared__ __attribute__((aligned(16))) unsigned char lds[];
    cg::grid_group grid = cg::this_grid();
    { volatile LAS unsigned* st0 = (volatile LAS unsigned*)((LAS unsigned char*)lds + LDS_BAR_OFF); if (threadIdx.x < 4) st0[threadIdx.x] = 0u; }
    __syncthreads();
    XcdBarrier xbar = xcd_barrier_post((unsigned*)(a.ws + OFF_BAR), (volatile LAS unsigned*)((LAS unsigned char*)lds + LDS_BAR_OFF));
    const int lo = a.lo, hi = a.hi, G = gridDim.x, bx = blockIdx.x;
#ifndef PHMASK
#define PHMASK 0x7ffff
#endif
#define IN(k) (((PHMASK >> (k)) & 1) && lo <= (k) && (k) < hi)
#ifndef REPMASK
#define REPMASK 0
#endif
#define REPS(k) for (int rep_ = 0; rep_ < ((((REPMASK) >> (k)) & 1) ? 2 : 1); ++rep_)
#define SEAM(k) do { if (IN(k) && IN((k) + 1)) { if (a.lo < 0) grid.sync(); xcd_barrier(xbar); } } while (0)
    unsigned char* ws = a.ws; const bf16_t* wb = (const bf16_t*)a.out;
    bf16_t* HB = (bf16_t*)(ws + OFF_HBUF); bf16_t* PB = (bf16_t*)(ws + OFF_PBUF); bf16_t* HID = (bf16_t*)(ws + OFF_HID);
    float* Z = (float*)(ws + OFF_Z); float* XA = (float*)(ws + OFF_XA); const float* modr = (const float*)(ws + OFF_MODR);
    const float* lng = a.in[6]; const float* lnb = a.in[7]; float* PART = (float*)((unsigned char*)a.out + WO_PART);
    if (IN(0)) { { phase0(a, lds); } if ((REPMASK >> 0) & 1) { phase0(a, lds); } }
    SEAM(0);
    if (IN(1)) { { phase1(a, lds); } if ((REPMASK >> 1) & 1) { phase1(a, lds); } }
    SEAM(1);
    if (IN(2)) { { run_gemm(lds, HB, wb + WO_WIN0 / 2, T, 3072, 1024, G, bx, EpiStore{PB, PLD}); } if ((REPMASK >> 2) & 1) { run_gemm(lds, HB, wb + WO_WIN0 / 2, T, 3072, 1024, G, bx, EpiStore{PB, PLD}); } }
    SEAM(2);
    if (IN(3)) { { scan_passA(a, lds); ag_rows(a, 240, G - 240, 0, 128); ag_rows(a, 0, 240, 128, T / 16); } if ((REPMASK >> 3) & 1) { scan_passA(a, lds); ag_rows(a, 240, G - 240, 0, 128); ag_rows(a, 0, 240, 128, T / 16); } }
    if (IN(3)) conv_l1_tiles(a, lds, CJ0, CJ4 + 528);
    SEAM(3);
    if (IN(4)) { { if (bx < 192) scan_passB(a, lds); else run_gemm(lds, (const bf16_t*)(ws + OFF_AG), wb + WO_BG / 2, T, 1024, 384, G - 192, bx - 192, EpiStore{HB, D}); } if ((REPMASK >> 4) & 1) { if (bx < 192) scan_passB(a, lds); else run_gemm(lds, (const bf16_t*)(ws + OFF_AG), wb + WO_BG / 2, T, 1024, 384, G - 192, bx - 192, EpiStore{HB, D}); } }
    SEAM(4);
    if (IN(5)) { { scan_passC(a, lds); } if ((REPMASK >> 5) & 1) { scan_passC(a, lds); } }
    if (IN(5)) conv_l1_tiles(a, lds, CJ4 + 528, CJ9);
    SEAM(5);
    if (IN(6)) { { readout_rows(a); } if ((REPMASK >> 6) & 1) { readout_rows(a); } }
    SEAM(6);
    if (IN(7)) { { { run_gemm(lds, HB, wb + WO_WO0 / 2, TL, 1024, 1024, G, bx, EpiRes{a.in[0], a.in[2], modr + 2 * 1024, modr + 6144 + 2 * 1024, Z}); if (bx < 16) { const int sl = bx >> 2; run_slice(lds, HB + (size_t)TL * 1024 + sl * 256, wb + WO_WO0 / 2 + sl * 256, 1024, bx & 3, EpiPart{PART + (size_t)sl * 256 * D}); } } } if ((REPMASK >> 7) & 1) { { run_gemm(lds, HB, wb + WO_WO0 / 2, TL, 1024, 1024, G, bx, EpiRes{a.in[0], a.in[2], modr + 2 * 1024, modr + 6144 + 2 * 1024, Z}); if (bx < 16) { const int sl = bx >> 2; run_slice(lds, HB + (size_t)TL * 1024 + sl * 256, wb + WO_WO0 / 2 + sl * 256, 1024, bx & 3, EpiPart{PART + (size_t)sl * 256 * D}); } } } }
    SEAM(7);
    if (IN(8)) { { ln_pass(Z, T, lng, lnb, XA, HB, modr, 3, 4, PART, 4, a.in[2], modr + 6144 + 2 * 1024); } if ((REPMASK >> 8) & 1) { ln_pass(Z, T, lng, lnb, XA, HB, modr, 3, 4, PART, 4, a.in[2], modr + 6144 + 2 * 1024); } }
    SEAM(8);
    if (IN(9)) { { run_gemm(lds, HB, wb + WO_WUP0 / 2, T, 2 * DFF, 1024, G, bx, EpiSwiglu{HID}); } if ((REPMASK >> 9) & 1) { run_gemm(lds, HB, wb + WO_WUP0 / 2, T, 2 * DFF, 1024, G, bx, EpiSwiglu{HID}); } }
    SEAM(9);
    if (IN(10)) { { { run_gemm(lds, HID, wb + WO_WDN0 / 2, TL, 1024, DFF, G, bx, EpiRes{XA, XA + (size_t)TL * D, modr + 5 * 1024, modr + 6144 + 5 * 1024, Z}); if (bx < 44) { const int sl = bx >> 2; run_slice(lds, HID + (size_t)TL * DFF + sl * 256, wb + WO_WDN0 / 2 + sl * 256, DFF, bx & 3, EpiPart{PART + (size_t)sl * 256 * D}); } } } if ((REPMASK >> 10) & 1) { { run_gemm(lds, HID, wb + WO_WDN0 / 2, TL, 1024, DFF, G, bx, EpiRes{XA, XA + (size_t)TL * D, modr + 5 * 1024, modr + 6144 + 5 * 1024, Z}); if (bx < 44) { const int sl = bx >> 2; run_slice(lds, HID + (size_t)TL * DFF + sl * 256, wb + WO_WDN0 / 2 + sl * 256, DFF, bx & 3, EpiPart{PART + (size_t)sl * 256 * D}); } } } }
    SEAM(10);
    if (IN(11)) { { ln_pass(Z, T, lng + 1024, lnb + 1024, XA, HB, modr + 2 * 6144, 0, 1, PART, 11, XA + (size_t)TL * D, modr + 6144 + 5 * 1024); } if ((REPMASK >> 11) & 1) { ln_pass(Z, T, lng + 1024, lnb + 1024, XA, HB, modr + 2 * 6144, 0, 1, PART, 11, XA + (size_t)TL * D, modr + 6144 + 5 * 1024); } }
    SEAM(11);
    if (IN(12)) { { run_gemm(lds, HB, wb + WO_WIN1 / 2, T, 3072, 1024, G, bx, EpiQKV{(bf16_t*)(ws + OFF_QK), (bf16_t*)(ws + OFF_VT)}); } if ((REPMASK >> 12) & 1) { run_gemm(lds, HB, wb + WO_WIN1 / 2, T, 3072, 1024, G, bx, EpiQKV{(bf16_t*)(ws + OFF_QK), (bf16_t*)(ws + OFF_VT)}); } }
    SEAM(12);
    if (IN(13)) { { natten(a, lds); } if ((REPMASK >> 13) & 1) { natten(a, lds); } }
    SEAM(13);
    if (IN(14)) { { run_gemm(lds, HB, wb + WO_WO1 / 2, TL, 1024, 1024, G, bx, EpiRes{XA, XA + (size_t)TL * D, modr + 2 * 6144 + 2 * 1024, modr + 3 * 6144 + 2 * 1024, Z}); } if ((REPMASK >> 14) & 1) { run_gemm(lds, HB, wb + WO_WO1 / 2, TL, 1024, 1024, G, bx, EpiRes{XA, XA + (size_t)TL * D, modr + 2 * 6144 + 2 * 1024, modr + 3 * 6144 + 2 * 1024, Z}); } }
    SEAM(14);
    if (IN(15)) { { ln_pass(Z, TL, lng + 2048, lnb + 2048, XA, HB, modr + 2 * 6144, 3, 4); } if ((REPMASK >> 15) & 1) { ln_pass(Z, TL, lng + 2048, lnb + 2048, XA, HB, modr + 2 * 6144, 3, 4); } }
    SEAM(15);
    if (IN(16)) { { run_gemm(lds, HB, wb + WO_WUP1 / 2, TL, 2 * DFF, 1024, G, bx, EpiSwiglu{HID}); } if ((REPMASK >> 16) & 1) { run_gemm(lds, HB, wb + WO_WUP1 / 2, TL, 2 * DFF, 1024, G, bx, EpiSwiglu{HID}); } }
    SEAM(16);
    if (IN(17)) { { run_gemm(lds, HID, wb + WO_WDN1 / 2, TL, 1024, DFF, G, bx, EpiRes{XA, XA + (size_t)TL * D, modr + 2 * 6144 + 5 * 1024, modr + 3 * 6144 + 5 * 1024, Z}); } if ((REPMASK >> 17) & 1) { run_gemm(lds, HID, wb + WO_WDN1 / 2, TL, 1024, DFF, G, bx, EpiRes{XA, XA + (size_t)TL * D, modr + 2 * 6144 + 5 * 1024, modr + 3 * 6144 + 5 * 1024, Z}); } }
    SEAM(17);
    if (IN(18)) { { ln_pass(Z, TL, lng + 3072, lnb + 3072, a.out, nullptr, nullptr, 0, 0); } if ((REPMASK >> 18) & 1) { ln_pass(Z, TL, lng + 3072, lnb + 3072, a.out, nullptr, nullptr, 0, 0); } }
}
constexpr int NPHASE = 19;
#ifndef MK_MULTI
#define MK_MULTI 0
#endif
extern "C" void kernel_launch(void* const* d_in, const int* in_sizes, int n_in, void* d_out, int out_size, void* d_ws, size_t ws_size, hipStream_t stream) {
    static int grid = 0;
    if (grid == 0) {
        if (n_in != 29 || out_size != TL * D || ws_size < WS_END) { fprintf(stderr, "kernel_launch: unexpected sizes n_in %d out %d ws %zu (need %zu)\n", n_in, out_size, ws_size, (size_t)WS_END); grid = -1; return; }
        int dev = 0, cus = 0, per_cu = 0;
        hipGetDevice(&dev); hipDeviceGetAttribute(&cus, hipDeviceAttributeMultiprocessorCount, dev);
        if (hipFuncSetAttribute((const void*)mega, hipFuncAttributeMaxDynamicSharedMemorySize, LDS_BYTES) != hipSuccess) { fprintf(stderr, "kernel_launch: hipFuncSetAttribute failed\n"); grid = -1; return; }
        if (hipOccupancyMaxActiveBlocksPerMultiprocessor(&per_cu, (const void*)mega, 512, LDS_BYTES) != hipSuccess || per_cu < 1) { fprintf(stderr, "kernel_launch: occupancy query says %d blocks/CU\n", per_cu); (void)hipGetLastError(); per_cu = 1; }
        grid = cus * (per_cu >= 1 ? 1 : 0);
        if (grid != 256) { fprintf(stderr, "kernel_launch: built for a 256-CU device, got %d\n", grid); if (grid > 256) grid = 256; }
    }
    if (grid < 240) return;
    if (hipMemsetAsync((char*)d_ws + OFF_BAR, 0, XCD_BAR_WORDS * 4, stream) != hipSuccess) { fprintf(stderr, "kernel_launch: memset of barrier words failed\n"); return; }
    Args a{};
    for (int i = 0; i < 29; ++i) a.in[i] = (const float*)d_in[i];
    a.out = (float*)d_out; a.ws = (unsigned char*)d_ws;
#if MK_MULTI
    for (int k = 0; k < NPHASE; ++k) { a.lo = k; a.hi = k + 1; hipLaunchKernelGGL(mega, dim3(grid), dim3(512), LDS_BYTES, stream, a); }
#else
    a.lo = 0; a.hi = NPHASE;
    void* args[] = {&a};
    hipError_t e = hipLaunchCooperativeKernel((const void*)mega, dim3(grid), dim3(512), args, LDS_BYTES, stream);
    if (e != hipSuccess) fprintf(stderr, "kernel_launch: cooperative launch failed: %s (grid %d)\n", hipGetErrorString(e), grid);
#endif
}
```

```cpp
#define DEPC_ 3
#define DEPA_ 2
#define PFA 1
#include <hip/hip_runtime.h>
#include <hip/hip_cooperative_groups.h>
#include <cstdio>
#include <cstdint>
namespace cg = cooperative_groups;
namespace pg8 {
#define PG8_LAS __attribute__((address_space(3)))
typedef unsigned short bf16_t;
typedef short bf16x8 __attribute__((ext_vector_type(8)));
typedef float f32x4 __attribute__((ext_vector_type(4)));
typedef unsigned u32x4 __attribute__((ext_vector_type(4)));
constexpr int BM = 256, BK = 64, HALF = 128, HTB = HALF * BK * 2  , STAGE_BYTES = 8 * HTB, NXCD = 8, WGM = 8;

__host__ __device__ __forceinline__ int lds_byte(int r, int c) { const int st = (r >> 4) * 2 + (c >> 5), rr = r & 15, cc = c & 31, ob = rr * 64 + cc * 2; return st * 1024 + (ob ^ (((ob >> 9) & 1) << 5)); }
__host__ __device__ __forceinline__ void stage_rc(int b, int& R, int& C) { const int st = b / 1024, sb = b % 1024, swz = sb ^ (((sb >> 9) & 1) << 5); R = (st >> 1) * 16 + swz / 64; C = (st & 1) * 32 + (swz % 64) / 2; }
__host__ __device__ __forceinline__ int perm32(int rho) { const int n = rho >> 4, i = rho & 15; return 8 * (i >> 2) + 4 * n + (i & 3); }

struct Unit { int pm, pn; };
struct Gemm { const bf16_t* A; const bf16_t* Bt; int M, N, K, ld; };

struct StaticOrder {
    int nM, nN, nwg, G, c;
    __host__ __device__ void init(int M, int N, int G_, int c_) { nM = M / BM; nN = N / BM; nwg = nM * nN; G = G_; c = c_; }
    __host__ __device__ bool next(int i, Unit& u) const {
        const long L = (long)i * G + c; if (L >= nwg) return false;
        int wgid = (int)L; { const int q = nwg / NXCD, r = nwg % NXCD, xcd = wgid % NXCD, off = wgid / NXCD; wgid = (xcd < r ? xcd * (q + 1) : r * (q + 1) + (xcd - r) * q) + off; }
        const int nig = WGM * nN, gid = wgid / nig, fm = gid * WGM, gsz = (nM - fm) < WGM ? (nM - fm) : WGM;
        u.pm = fm + ((wgid % nig) % gsz); u.pn = (wgid % nig) / gsz; return true;
    }
    __device__ __forceinline__ void a_ready(const Unit&) const {}
    __device__ __forceinline__ void done(const Unit&) const {}
};

__device__ __forceinline__ unsigned cvt_pk_bf16(float lo, float hi) { unsigned r; asm volatile("v_cvt_pk_bf16_f32 %0, %1, %2" : "=v"(r) : "v"(lo), "v"(hi)); return r; }
template <class Epi, class Sched, bool ALIGN_EPI = false, bool SP2 = false>
__device__ __forceinline__ void gemm_phase(PG8_LAS unsigned char* lds, const Gemm g, const Sched& S, const Epi& E) {
    const int tid = threadIdx.x, wid = __builtin_amdgcn_readfirstlane(tid >> 6), lane = tid & 63, wr = wid >> 2, wc = wid & 3, fr = lane & 15, fq = lane >> 4;
    const int K = g.K, nt = K / BK, LD = g.ld;
    unsigned voffA[2], voffB[2];
#pragma unroll
    for (int i = 0; i < 2; ++i) { int R, C; stage_rc(tid * 16 + i * 8192, R, C); const int Rb = Epi::PERM ? ((R & ~31) + perm32(R & 31)) : R;
        voffA[i] = (unsigned)(R * LD + C) * 2u; voffB[i] = (unsigned)(Rb * LD + C) * 2u; }
    const size_t kstep = (size_t)(BK * 2);
    const size_t hstep = (size_t)HALF * LD * 2;
    const size_t tstep = 2 * hstep;
    const unsigned ldsw = (unsigned)wid * 1024u;
    const int aoff = lds_byte(wr * 64 + fr, fq * 8), boff = lds_byte(wc * 32 + fr, fq * 8);
#define PG8_SA(b, h) (((b) * 2 + (h)) * HTB)
#define PG8_SB(b, h) ((4 + (b) * 2 + (h)) * HTB)
#define PG8_STAGE(bufoff, gbase, voff) do { _Pragma("unroll") for (int _i = 0; _i < 2; ++_i) \
        __builtin_amdgcn_global_load_lds((const unsigned*)((const char*)(gbase) + (voff)[_i]), (PG8_LAS unsigned*)(lds + (bufoff) + ldsw + _i * 8192), 16, 0, 0); } while (0)
#define PG8_LDA(dst, b, h) do { _Pragma("unroll") for (int m = 0; m < 4; ++m) _Pragma("unroll") for (int k = 0; k < 2; ++k) dst[m][k] = *(const PG8_LAS bf16x8*)(lds + PG8_SA(b, h) + aoff + m * 2048 + k * 1024); } while (0)
#define PG8_LDB(dst, b, h) do { _Pragma("unroll") for (int n = 0; n < 2; ++n) _Pragma("unroll") for (int k = 0; k < 2; ++k) dst[n][k] = *(const PG8_LAS bf16x8*)(lds + PG8_SB(b, h) + boff + n * 2048 + k * 1024); } while (0)
#define PG8_MMA(ai, bj, At, Bt) do { __builtin_amdgcn_s_setprio(1); _Pragma("unroll") for (int m = 0; m < 4; ++m) _Pragma("unroll") for (int n = 0; n < 2; ++n) _Pragma("unroll") for (int k = 0; k < 2; ++k) \
        acc[ai][bj][m][n] = __builtin_amdgcn_mfma_f32_16x16x32_bf16(Bt[n][k], At[m][k], acc[ai][bj][m][n], 0, 0, 0); __builtin_amdgcn_s_setprio(0); } while (0)
#define PG8_WAIT_V(n) asm volatile("s_waitcnt vmcnt(" #n ")" ::: "memory")
#define PG8_WAIT_L(n) asm volatile("s_waitcnt lgkmcnt(" #n ")" ::: "memory")
#define PG8_BAR __builtin_amdgcn_s_barrier()
#define PG8_SCHED __builtin_amdgcn_sched_barrier(0)
    Unit cur, nxt; int ui = 0;
    if (!S.next(0, cur)) return;
    f32x4 acc[2][2][4][2];
#pragma unroll
    for (int a = 0; a < 2; ++a)
#pragma unroll
        for (int b = 0; b < 2; ++b)
#pragma unroll
            for (int m = 0; m < 4; ++m)
#pragma unroll
                for (int n = 0; n < 2; ++n) acc[a][b][m][n] = (f32x4){0.f, 0.f, 0.f, 0.f};
    bf16x8 At[4][2], B0[2][2], B1[2][2];
    const char* cA = (const char*)g.A + (size_t)cur.pm * tstep; const char* cB = (const char*)g.Bt + (size_t)cur.pn * tstep;
    S.a_ready(cur);
    if constexpr (SP2) {
        PG8_STAGE(PG8_SB(0, 0), cB, voffB); PG8_STAGE(PG8_SB(0, 1), cB + hstep, voffB); PG8_STAGE(PG8_SA(0, 0), cA, voffA); PG8_STAGE(PG8_SA(0, 1), cA + hstep, voffA);
        if (wr == 1) PG8_BAR;
        PG8_WAIT_V(2); PG8_BAR;
        PG8_STAGE(PG8_SB(1, 0), cB + kstep, voffB); PG8_STAGE(PG8_SA(1, 0), cA + kstep, voffA); PG8_STAGE(PG8_SB(1, 1), cB + hstep + kstep, voffB);
        PG8_WAIT_V(6); PG8_BAR;
    } else {
        PG8_STAGE(PG8_SB(0, 0), cB, voffB); PG8_STAGE(PG8_SA(0, 0), cA, voffA); PG8_STAGE(PG8_SB(0, 1), cB + hstep, voffB); PG8_STAGE(PG8_SA(0, 1), cA + hstep, voffA);
        if (wr == 1) PG8_BAR;
        PG8_WAIT_V(4); PG8_BAR;
        PG8_STAGE(PG8_SB(1, 0), cB + kstep, voffB); PG8_STAGE(PG8_SA(1, 0), cA + kstep, voffA); PG8_STAGE(PG8_SB(1, 1), cB + hstep + kstep, voffB);
        PG8_WAIT_V(6); PG8_BAR;
    }
    for (;;) {
        const bool has_next = S.next(ui + 1, nxt);
        const char* nA = has_next ? (const char*)g.A + (size_t)nxt.pm * tstep : cA; const char* nB = has_next ? (const char*)g.Bt + (size_t)nxt.pn * tstep : cB;
        for (int t = 0; t < nt; t += 2) {
            const bool last = (t == nt - 2);
            const char* a1 = cA + (size_t)(t + 1) * kstep;
            const char* a2 = last ? nA : cA + (size_t)(t + 2) * kstep; const char* b2 = last ? nB : cB + (size_t)(t + 2) * kstep;
            const char* a3 = a2 + kstep; const char* b3 = b2 + kstep;
            if (last && has_next) S.a_ready(nxt);
            if constexpr (SP2) {
            PG8_LDB(B0, 0, 0); PG8_LDB(B1, 0, 1); PG8_SCHED; PG8_LDA(At, 0, 0); PG8_STAGE(PG8_SA(1, 1), a1 + hstep, voffA);
            PG8_WAIT_V(8); PG8_WAIT_L(0); PG8_BAR; PG8_MMA(0, 0, At, B0); PG8_MMA(0, 1, At, B1); PG8_BAR; PG8_SCHED;
            PG8_LDA(At, 0, 1); PG8_STAGE(PG8_SB(0, 0), b2, voffB); PG8_STAGE(PG8_SB(0, 1), b2 + hstep, voffB); PG8_STAGE(PG8_SA(0, 0), a2, voffA);
            PG8_WAIT_V(8); PG8_WAIT_L(0); PG8_BAR; PG8_MMA(1, 0, At, B0); PG8_MMA(1, 1, At, B1); PG8_BAR; PG8_SCHED;
            PG8_LDB(B0, 1, 0); PG8_LDB(B1, 1, 1); PG8_SCHED; PG8_LDA(At, 1, 0); PG8_STAGE(PG8_SA(0, 1), a2 + hstep, voffA);
            PG8_WAIT_V(8); PG8_WAIT_L(0); PG8_BAR; PG8_MMA(0, 0, At, B0); PG8_MMA(0, 1, At, B1); PG8_BAR; PG8_SCHED;
            PG8_LDA(At, 1, 1); PG8_STAGE(PG8_SB(1, 0), b3, voffB); PG8_STAGE(PG8_SB(1, 1), b3 + hstep, voffB); PG8_STAGE(PG8_SA(1, 0), a3, voffA);
            PG8_WAIT_V(8); PG8_WAIT_L(0); PG8_BAR; PG8_MMA(1, 0, At, B0); PG8_MMA(1, 1, At, B1); PG8_BAR; PG8_SCHED;
            } else {
            PG8_LDB(B0, 0, 0); PG8_SCHED; PG8_LDA(At, 0, 0); PG8_STAGE(PG8_SA(1, 1), a1 + hstep, voffA);
            PG8_WAIT_L(8); PG8_BAR; PG8_WAIT_L(0); PG8_MMA(0, 0, At, B0); PG8_BAR; PG8_SCHED;
            PG8_LDB(B1, 0, 1); PG8_STAGE(PG8_SB(0, 0), b2, voffB);
            PG8_BAR; PG8_WAIT_L(0); PG8_MMA(0, 1, At, B1); PG8_BAR;
            PG8_LDA(At, 0, 1); PG8_STAGE(PG8_SA(0, 0), a2, voffA);
            PG8_BAR; PG8_WAIT_L(0); PG8_MMA(1, 0, At, B0); PG8_BAR; PG8_SCHED;
            PG8_STAGE(PG8_SB(0, 1), b2 + hstep, voffB);
            PG8_WAIT_V(6); PG8_BAR; PG8_MMA(1, 1, At, B1); PG8_BAR;
            PG8_LDB(B0, 1, 0); PG8_SCHED; PG8_LDA(At, 1, 0); PG8_STAGE(PG8_SA(0, 1), a2 + hstep, voffA);
            PG8_WAIT_L(8); PG8_BAR; PG8_WAIT_L(0); PG8_MMA(0, 0, At, B0); PG8_BAR; PG8_SCHED;
            PG8_LDB(B1, 1, 1); PG8_STAGE(PG8_SB(1, 0), b3, voffB);
            PG8_BAR; PG8_WAIT_L(0); PG8_MMA(0, 1, At, B1); PG8_BAR;
            PG8_LDA(At, 1, 1); PG8_STAGE(PG8_SA(1, 0), a3, voffA);
            PG8_BAR; PG8_WAIT_L(0); PG8_MMA(1, 0, At, B0); PG8_BAR; PG8_SCHED;
            PG8_STAGE(PG8_SB(1, 1), b3 + hstep, voffB);
            PG8_WAIT_V(6); PG8_BAR; PG8_MMA(1, 1, At, B1); PG8_BAR;
            }
        }
        if constexpr (ALIGN_EPI) { if (wr == 0) PG8_BAR; }
        if constexpr (!Epi::AFTER_DRAIN) { E(acc, cur, wr, wc, fr, fq); S.done(cur); }
        if (!has_next) break;
#pragma unroll
        for (int a = 0; a < 2; ++a)
#pragma unroll
            for (int b = 0; b < 2; ++b)
#pragma unroll
                for (int m = 0; m < 4; ++m)
#pragma unroll
                    for (int n = 0; n < 2; ++n) acc[a][b][m][n] = (f32x4){0.f, 0.f, 0.f, 0.f};
        cur = nxt; cA = nA; cB = nB; ++ui;
        if constexpr (ALIGN_EPI) { if (wr == 1) PG8_BAR; }
    }
    PG8_WAIT_V(0);
    if constexpr (!ALIGN_EPI) { if (wr == 0) PG8_BAR; }
    PG8_BAR;
    if constexpr (Epi::AFTER_DRAIN) { E.fused(acc, cur, wr, wc, fr, fq, lds, wid, lane); S.done(cur); }
#undef PG8_SA
#undef PG8_SB
#undef PG8_STAGE
#undef PG8_LDA
#undef PG8_LDB
#undef PG8_MMA
#undef PG8_WAIT_V
#undef PG8_WAIT_L
#undef PG8_BAR
#undef PG8_SCHED
}
}
using pg8::bf16_t; using pg8::bf16x8; using pg8::f32x4; using pg8::Unit;
typedef float f32x2 __attribute__((ext_vector_type(2)));
typedef unsigned u32x4 __attribute__((ext_vector_type(4)));
typedef unsigned u32x2 __attribute__((ext_vector_type(2)));

constexpr int TL = 16384, TC = 256, T = TL + TC, D = 1024, DFF = 2816, DA = 768;
constexpr int PLD = 3072;
constexpr int NC = 80, CH = 208, NS = 8;
constexpr float ALPHA = 1.41421356237f, LN_EPS = 1e-6f, GN_EPS = 64e-5f;
constexpr int KS = 8;
constexpr size_t OFF_PBUF = 0, OFF_Z = 0, OFF_QK = 0;
constexpr size_t OFF_HID = 68157440ull, OFF_VT = 68157440ull;
constexpr size_t OFF_PQ = 102236160ull, OFF_Y = 165150720ull, OFF_AG = 216268800ull;
constexpr size_t OFF_XA = 161873920ull, OFF_HBUF = 230031360ull;
constexpr size_t OFF_MODP = 264110080ull, OFF_MODR = OFF_MODP + 786432ull, OFF_COEF = OFF_MODR + 98304ull, OFF_BAR = OFF_COEF + 1597440ull, WS_END = OFF_BAR + 16384ull;
constexpr size_t WO_WIN0 = 0, WO_WO0 = 6291456, WO_WUP0 = 8388608, WO_WDN0 = 19922944, WO_WIN1 = 25690112, WO_WO1 = 31981568, WO_WUP1 = 34078720, WO_WDN1 = 45613056,
                 WO_W2T = 51380224, WO_A2T = 51576832, WO_BG = 51773440, WO_PART = 52559872;
constexpr int WAVE_LDS = 16896, LDS_BAR_OFF = 8 * WAVE_LDS + 22272, LDS_BYTES = LDS_BAR_OFF + 16;

struct Args { const float* in[29]; float* out; unsigned char* ws; int lo, hi; };

__device__ __forceinline__ unsigned f2bf(float f) { unsigned u = __builtin_bit_cast(unsigned, f); return (u + 0x7fffu + ((u >> 16) & 1u)) >> 16; }
__device__ __forceinline__ float bf2f(unsigned short b) { return __builtin_bit_cast(float, ((unsigned)b) << 16); }
__device__ __forceinline__ unsigned pk2(float lo, float hi) { return f2bf(lo) | (f2bf(hi) << 16); }
template <int CTRL> __device__ __forceinline__ float dppf(float x) { return __builtin_bit_cast(float, __builtin_amdgcn_update_dpp(0, __builtin_bit_cast(int, x), CTRL, 0xf, 0xf, true)); }
__device__ __forceinline__ float sum16(float v) { v += dppf<0xB1>(v); v += dppf<0x4E>(v); v += dppf<0x124>(v); v += dppf<0x128>(v); return v; }
__device__ __forceinline__ float xsum16(float v) { return v + __shfl_xor(v, 16); }
__device__ __forceinline__ float xsum32(float v) { return v + __shfl_xor(v, 32); }
__device__ __forceinline__ float xmax16(float v) { return fmaxf(v, __shfl_xor(v, 16)); }
__device__ __forceinline__ float xmax32(float v) { return fmaxf(v, __shfl_xor(v, 32)); }
__device__ __forceinline__ float wsum(float v) { return xsum32(xsum16(sum16(v))); }
__device__ __forceinline__ float rcp_(float x) { return __builtin_amdgcn_rcpf(x); }
__device__ __forceinline__ float sigm(float x) { return rcp_(1.f + __expf(-x)); }
__device__ __forceinline__ void wave_sync() { __builtin_amdgcn_fence(__ATOMIC_SEQ_CST, "wavefront"); __builtin_amdgcn_wave_barrier(); }

struct EpiStore {
    static constexpr bool PERM = true, AFTER_DRAIN = false;
    bf16_t* O; int ldc;
    __device__ __forceinline__ void operator()(const f32x4 (&acc)[2][2][4][2], const Unit& u, int wr, int wc, int fr, int fq) const {
        const int row0 = u.pm * 256 + wr * 64 + fr, col0 = u.pn * 256 + wc * 32 + 8 * fq;
#pragma unroll
        for (int ai = 0; ai < 2; ++ai)
#pragma unroll
            for (int m = 0; m < 4; ++m) { bf16_t* rp = O + (size_t)(row0 + ai * 128 + m * 16) * ldc + col0;
#pragma unroll
                for (int bj = 0; bj < 2; ++bj) { const f32x4 a = acc[ai][bj][m][0], b = acc[ai][bj][m][1]; u32x4 w; w.x = pk2(a[0], a[1]); w.y = pk2(a[2], a[3]); w.z = pk2(b[0], b[1]); w.w = pk2(b[2], b[3]); *(u32x4*)(rp + bj * 128) = w; } }
    }
};
struct EpiQKV {
    static constexpr bool PERM = true, AFTER_DRAIN = false;
    bf16_t* QK; bf16_t* Vt;
    __device__ __forceinline__ void operator()(const f32x4 (&acc)[2][2][4][2], const Unit& u, int wr, int wc, int fr, int fq) const {
        const int row0 = u.pm * 256 + wr * 64 + fr, col0 = u.pn * 256 + wc * 32 + 8 * fq;
        if (u.pn < 8) {
#pragma unroll
            for (int ai = 0; ai < 2; ++ai)
#pragma unroll
                for (int m = 0; m < 4; ++m) { bf16_t* rp = QK + (size_t)(row0 + ai * 128 + m * 16) * 2048 + col0;
#pragma unroll
                    for (int bj = 0; bj < 2; ++bj) { const f32x4 a = acc[ai][bj][m][0], b = acc[ai][bj][m][1]; u32x4 w; w.x = pk2(a[0], a[1]); w.y = pk2(a[2], a[3]); w.z = pk2(b[0], b[1]); w.w = pk2(b[2], b[3]); *(u32x4*)(rp + bj * 128) = w; } }
        } else {
            bf16_t* vb = Vt + (size_t)(col0 - 2048) * T + row0;
#pragma unroll 1
            for (int bj = 0; bj < 2; ++bj)
#pragma unroll
                for (int n = 0; n < 2; ++n)
#pragma unroll
                    for (int e = 0; e < 4; ++e) { bf16_t* cp = vb + (size_t)(bj * 128 + 4 * n + e) * T;
#pragma unroll
                        for (int ai = 0; ai < 2; ++ai)
#pragma unroll
                            for (int m = 0; m < 4; ++m) cp[ai * 128 + m * 16] = (bf16_t)f2bf(bj ? acc[ai][1][m][n][e] : acc[ai][0][m][n][e]); }
        }
    }
};
struct EpiSwiglu {
    static constexpr bool PERM = true, AFTER_DRAIN = false;
    bf16_t* O;
    __device__ __forceinline__ void operator()(const f32x4 (&acc)[2][2][4][2], const Unit& u, int wr, int wc, int fr, int fq) const {
        const int row0 = u.pm * 256 + wr * 64 + fr, col0 = u.pn * 128 + wc * 32 + 8 * fq;
#pragma unroll
        for (int ai = 0; ai < 2; ++ai)
#pragma unroll
            for (int m = 0; m < 4; ++m) { float h[8];
#pragma unroll
                for (int n = 0; n < 2; ++n)
#pragma unroll
                    for (int e = 0; e < 4; ++e) { const float a = acc[ai][0][m][n][e], b = acc[ai][1][m][n][e]; h[n * 4 + e] = a * sigm(a) * b; }
                u32x4 w; w.x = pk2(h[0], h[1]); w.y = pk2(h[2], h[3]); w.z = pk2(h[4], h[5]); w.w = pk2(h[6], h[7]);
                *(u32x4*)(O + (size_t)(row0 + ai * 128 + m * 16) * DFF + col0) = w; }
    }
};
struct EpiRes {
    static constexpr bool PERM = true, AFTER_DRAIN = false;
    const float* xlat; const float* xctx; const float* glat; const float* gctx; float* Z;
    __device__ __forceinline__ void operator()(const f32x4 (&acc)[2][2][4][2], const Unit& u, int wr, int wc, int fr, int fq) const {
        const int row0 = u.pm * 256 + wr * 64 + fr, col0 = u.pn * 256 + wc * 32 + 8 * fq;
        const bool isctx = (u.pm * 256 >= TL);
        const float* gate = isctx ? gctx : glat;
        f32x4 gv[2][2];
#pragma unroll
        for (int bj = 0; bj < 2; ++bj)
#pragma unroll
            for (int n = 0; n < 2; ++n) gv[bj][n] = *(const f32x4*)(gate + col0 + bj * 128 + 4 * n);
#pragma unroll
        for (int ai = 0; ai < 2; ++ai)
#pragma unroll
            for (int m = 0; m < 4; ++m) { const int row = row0 + ai * 128 + m * 16;
                const float* xr = isctx ? xctx + (size_t)(row - TL) * D : xlat + (size_t)row * D; float* zr = Z + (size_t)row * D;
#pragma unroll
                for (int bj = 0; bj < 2; ++bj)
#pragma unroll
                    for (int n = 0; n < 2; ++n) { const int c = col0 + bj * 128 + 4 * n; const f32x4 xv = *(const f32x4*)(xr + c); *(f32x4*)(zr + c) = xv * ALPHA + gv[bj][n] * acc[ai][bj][m][n]; } }
    }
};

struct EpiPart {
    static constexpr bool PERM = true, AFTER_DRAIN = false;
    float* P;
    __device__ __forceinline__ void operator()(const f32x4 (&acc)[2][2][4][2], const Unit& u, int wr, int wc, int fr, int fq) const {
        const int row0 = wr * 64 + fr, col0 = u.pn * 256 + wc * 32 + 8 * fq;
#pragma unroll
        for (int ai = 0; ai < 2; ++ai)
#pragma unroll
            for (int m = 0; m < 4; ++m) { float* zr = P + (size_t)(row0 + ai * 128 + m * 16) * D;
#pragma unroll
                for (int bj = 0; bj < 2; ++bj)
#pragma unroll
                    for (int n = 0; n < 2; ++n) *(f32x4*)(zr + col0 + bj * 128 + 4 * n) = acc[ai][bj][m][n]; }
    }
};
struct OneUnit { int pn;
    __device__ __forceinline__ bool next(int i, Unit& u) const { if (i != 0) return false; u.pm = 0; u.pn = pn; return true; }
    __device__ __forceinline__ void a_ready(const Unit&) const {}
    __device__ __forceinline__ void done(const Unit&) const {}
};
#define LAS __attribute__((address_space(3)))
#define XB_TMO      128
#define XB_XCNT(j)  (256  + 64 * (j))
#define XB_XSUB(j)  (1280 + 64 * (j))
#define XB_XGEN(j)  (2304 + 64 * (j))
#define XB_TOP      3328
#define XB_TOPGEN   3392
#define XCD_BAR_WORDS 3456
#define XB_SPIN_CAP (1u << 18)

__device__ __forceinline__ unsigned xb_ld(unsigned* p)              { return __hip_atomic_load(p, __ATOMIC_RELAXED, __HIP_MEMORY_SCOPE_AGENT); }
__device__ __forceinline__ unsigned xb_add(unsigned* p, unsigned v) { return __hip_atomic_fetch_add(p, v, __ATOMIC_RELAXED, __HIP_MEMORY_SCOPE_AGENT); }
__device__ __forceinline__ unsigned xb_xcc_id() { return (unsigned)__builtin_amdgcn_s_getreg((3 << 11) | 20) & 0xFu; }
#define XB_SPIN(cond, bar) do { unsigned _sp = 0; while (cond) { __builtin_amdgcn_s_sleep(1); \
    if ((++_sp & 255u) == 0u) { if (xb_ld(&(bar)[XB_TMO])) break; if (_sp > XB_SPIN_CAP) { atomicAdd(&(bar)[XB_TMO], 1u); break; } } } } while (0)

struct XcdBarrier {
    unsigned* bar; unsigned x;
    volatile LAS unsigned* st;
};

__device__ __forceinline__ XcdBarrier xcd_barrier_post(unsigned* bar, volatile LAS unsigned* st) {
    XcdBarrier b; b.bar = bar; b.x = xb_xcc_id(); b.st = st;
    if (threadIdx.x == 0) (void)xb_add(&bar[XB_XCNT(b.x)], 1u);
    return b;
}
__device__ __forceinline__ void xcd_barrier_complete(unsigned* bar, unsigned x, unsigned& nloc, unsigned& nx) {
    const unsigned G = gridDim.x * gridDim.y * gridDim.z;
    unsigned sum, cnt, mine, sp = 0u;
    for (;;) {
        sum = 0u; cnt = 0u; mine = 0u;
#pragma unroll
        for (unsigned j = 0; j < 16; ++j) { const unsigned c = xb_ld(&bar[XB_XCNT(j)]); sum += c; cnt += (c > 0u) ? 1u : 0u; mine = (j == x) ? c : mine; }
        if (sum == G) break;
        __builtin_amdgcn_s_sleep(1);
        if ((++sp & 255u) == 0u) { if (xb_ld(&bar[XB_TMO])) break; if (sp > XB_SPIN_CAP) { atomicAdd(&bar[XB_TMO], 1u); break; } }
    }
    nloc = mine > 0u ? mine : 1u; nx = cnt > 0u ? cnt : 1u;
}

__device__ __forceinline__ void xcd_barrier(const XcdBarrier& b) {
    asm volatile("s_waitcnt vmcnt(0)" ::: "memory");
    __syncthreads();
    if (threadIdx.x == 0) {
        unsigned* bar = b.bar;
        __builtin_amdgcn_s_waitcnt(0);
        unsigned nloc = b.st[0], nx = b.st[1];
        if (nloc == 0u) { xcd_barrier_complete(bar, b.x, nloc, nx); b.st[0] = nloc; b.st[1] = nx; }
        const unsigned old = xb_add(&bar[XB_XSUB(b.x)], 1u);
        const unsigned gen = old / nloc;
        if (old + 1u == (gen + 1u) * nloc) {
            __builtin_amdgcn_fence(__ATOMIC_RELEASE, "agent");
            asm volatile("s_waitcnt vmcnt(0)" ::: "memory");
            const unsigned og = xb_add(&bar[XB_TOP], 1u);
            const unsigned tg = og / nx;
            if (og + 1u == (tg + 1u) * nx) xb_add(&bar[XB_TOPGEN], 1u);
            else XB_SPIN(xb_ld(&bar[XB_TOPGEN]) == tg, bar);
            __builtin_amdgcn_fence(__ATOMIC_ACQUIRE, "agent");
            xb_add(&bar[XB_XGEN(b.x)], 1u);
            asm volatile("s_waitcnt vmcnt(0)" ::: "memory");
        } else {
            XB_SPIN(xb_ld(&bar[XB_XGEN(b.x)]) == gen, bar);
            __builtin_amdgcn_fence(__ATOMIC_ACQUIRE, "agent");
            asm volatile("s_waitcnt vmcnt(0)" ::: "memory");
        }
    }
    __syncthreads();
}

__device__ __forceinline__ void tconv_tile(const float* __restrict__ W, int K, int N, bf16_t* __restrict__ dst, int ld, int mode, int tile, float* tl) {
    const int tid = threadIdx.x, tx = tid & 63, ty = tid >> 6;
    const int nkt = K >> 6, kt = tile % nkt, nt = tile / nkt, k0 = kt * 64, n0 = nt * 64;
#pragma unroll
    for (int rr = 0; rr < 8; ++rr) { const int kk = ty * 8 + rr; tl[kk * 65 + tx] = W[(size_t)(k0 + kk) * N + n0 + tx]; }
    __syncthreads();
#pragma unroll
    for (int rr = 0; rr < 8; ++rr) { const int nn = ty * 8 + rr, n = n0 + nn; const int row = (mode == 0) ? n : ((n >> 7) * 256 + (n & 127) + (mode == 2 ? 128 : 0));
        dst[(size_t)row * ld + k0 + tx] = (bf16_t)f2bf(tl[tx * 65 + nn]); }
    __syncthreads();
}
constexpr int CJ0 = 736, CJ1 = CJ0 + 256, CJ2 = CJ1 + 704, CJ3 = CJ2 + 704, CJ4 = CJ3 + 704, CJ5 = CJ4 + 768, CJ6 = CJ5 + 256, CJ7 = CJ6 + 704, CJ8 = CJ7 + 704, CJ9 = CJ8 + 704;
__device__ __forceinline__ void conv_tile_job(const Args& a, int t, float* tl) {
    bf16_t* wb = (bf16_t*)a.out;
    if (t < CJ0) tconv_tile(a.in[11], 1024, 2944, wb + WO_WIN0 / 2, 1024, 0, t, tl);
    else if (t < CJ1) tconv_tile(a.in[25], 1024, 1024, wb + WO_WO0 / 2, 1024, 0, t - CJ0, tl);
    else if (t < CJ2) tconv_tile(a.in[8], 1024, DFF, wb + WO_WUP0 / 2, 1024, 1, t - CJ1, tl);
    else if (t < CJ3) tconv_tile(a.in[9], 1024, DFF, wb + WO_WUP0 / 2, 1024, 2, t - CJ2, tl);
    else if (t < CJ4) tconv_tile(a.in[10], DFF, 1024, wb + WO_WDN0 / 2, DFF, 0, t - CJ3, tl);
    else if (t < CJ5) tconv_tile(a.in[26], 1024, 3072, wb + WO_WIN1 / 2, 1024, 0, t - CJ4, tl);
    else if (t < CJ6) tconv_tile(a.in[28], 1024, 1024, wb + WO_WO1 / 2, 1024, 0, t - CJ5, tl);
    else if (t < CJ7) tconv_tile(a.in[8] + (size_t)D * DFF, 1024, DFF, wb + WO_WUP1 / 2, 1024, 1, t - CJ6, tl);
    else if (t < CJ8) tconv_tile(a.in[9] + (size_t)D * DFF, 1024, DFF, wb + WO_WUP1 / 2, 1024, 2, t - CJ7, tl);
    else tconv_tile(a.in[10] + (size_t)D * DFF, DFF, 1024, wb + WO_WDN1 / 2, DFF, 0, t - CJ8, tl);
}
__device__ __forceinline__ void conv_l1_tiles(const Args& a, unsigned char* lds, int t_lo, int t_hi) {
    if ((int)blockIdx.x < 240) return;
    for (int t = t_lo + ((int)blockIdx.x - 240); t < t_hi; t += (int)gridDim.x - 240) conv_tile_job(a, t, (float*)lds);
}
__device__ __forceinline__ void phase0(const Args& a, unsigned char* lds) {
    float* tl = (float*)lds; const int tid = threadIdx.x;
    bf16_t* wb = (bf16_t*)a.out;
    float* modp = (float*)(a.ws + OFF_MODP);
    constexpr int NG = 2 * 12 * KS;
    for (int it = blockIdx.x; it < NG + CJ0; it += gridDim.x) {
        if (it < NG) {
            const int layer = it / (12 * KS), cb = (it % (12 * KS)) / KS, ks = it % KS, col = cb * 512 + tid;
            if (tid < 256) { const float v = (tid < 128) ? a.in[1][ks * 128 + tid] : a.in[3][ks * 128 + tid - 128]; tl[tid] = v * sigm(v); }
            __syncthreads();
            const float* W = a.in[4] + (size_t)layer * D * 6144 + (size_t)(ks * 128) * 6144 + col;
            float a0 = 0.f, a1 = 0.f;
#pragma unroll 8
            for (int k = 0; k < 128; ++k) { const float w = W[(size_t)k * 6144]; a0 += tl[k] * w; a1 += tl[128 + k] * w; }
            if (ks == 0) { const float b = a.in[5][layer * 6144 + col]; a0 += b; a1 += b; }
            modp[((layer * 2 + 0) * KS + ks) * 6144 + col] = a0; modp[((layer * 2 + 1) * KS + ks) * 6144 + col] = a1;
            __syncthreads();
        } else conv_tile_job(a, it - NG, tl);
    }
    constexpr int E0 = 128 * 1024, E1 = E0 + 98304, E2 = E1 + 98304, E3 = E2 + 393216;
    for (int e = blockIdx.x * 512 + tid; e < E3; e += gridDim.x * 512) {
        if (e < E0) wb[WO_WIN0 / 2 + (size_t)2944 * 1024 + e] = 0;
        else if (e < E1) { const int i = e - E0, d = i / 49152, r = (i % 49152) / 64, k = i % 64; wb[WO_W2T / 2 + i] = (bf16_t)f2bf(a.in[14][(d * 64 + k) * DA + r]); }
        else if (e < E2) { const int i = e - E1, d = i / 49152, r = (i % 49152) / 64, k = i % 64; wb[WO_A2T / 2 + i] = (bf16_t)f2bf(a.in[16][(d * 64 + k) * DA + r]); }
        else { const int i = e - E2, row = i / 384, col = i % 384; float v = 0.f;
            if (row < 768) { if (col < 128) v = a.in[17][col * DA + row]; }
            else { const int g = (row - 768) >> 6, dd = (row - 768) & 63, cc = col - 128 - g * 64; if (cc >= 0 && cc < 64) v = a.in[23][(g * 64 + cc) * 64 + dd] * a.in[24][row - 768]; }
            wb[WO_BG / 2 + i] = (bf16_t)f2bf(v); }
    }
}
__device__ __forceinline__ void phase1(const Args& a, unsigned char* lds) {
    const int tid = threadIdx.x, lane = tid & 63, wave = tid >> 6;
    const float* modp = (const float*)(a.ws + OFF_MODP); float* modr = (float*)(a.ws + OFF_MODR);
    const int gid = blockIdx.x * 512 + tid;
    if (gid < 4 * 6144) { const int lv = gid / 6144, col = gid % 6144; float s = 0.f;
#pragma unroll
        for (int k = 0; k < KS; ++k) s += modp[(lv * KS + k) * 6144 + col];
        modr[gid] = s; }
    float* ml = (float*)lds;
    for (int i = tid; i < 4096; i += 512) { const int which = i >> 10, col = i & 1023, vec = which >> 1, chunk = which & 1; float s = 0.f;
#pragma unroll
        for (int k = 0; k < KS; ++k) s += modp[((0 * 2 + vec) * KS + k) * 6144 + chunk * 1024 + col];
        ml[i] = s; }
    __syncthreads();
    bf16_t* H = (bf16_t*)(a.ws + OFF_HBUF);
#pragma unroll 2
    for (int row = blockIdx.x * 8 + wave; row < T; row += gridDim.x * 8) {
        const float* src = row < TL ? a.in[0] + (size_t)row * D : a.in[2] + (size_t)(row - TL) * D; const float* mm = ml + (row < TL ? 0 : 2048);
#pragma unroll
        for (int q = 0; q < 4; ++q) { const int col = q * 256 + lane * 4; const f32x4 v = *(const f32x4*)(src + col), sh = *(const f32x4*)(mm + col), sc = *(const f32x4*)(mm + 1024 + col);
            const f32x4 h = v * (sc + 1.0f) + sh; u32x2 w; w.x = pk2(h[0], h[1]); w.y = pk2(h[2], h[3]); *(u32x2*)(H + (size_t)row * D + col) = w; }
    }
    __syncthreads();
}
__device__ __forceinline__ void ln_pass(const float* __restrict__ Z, int rows, const float* __restrict__ g, const float* __restrict__ b, float* XO,
                                        bf16_t* __restrict__ H, const float* __restrict__ modr_layer  , int sh_idx, int sc_idx,
                                        const float* part = nullptr, int nsl = 0, const float* xres_ctx = nullptr, const float* gate_ctx = nullptr) {
    const int lane = threadIdx.x & 63, wave = threadIdx.x >> 6;
#pragma unroll 2
    for (int row = blockIdx.x * 8 + wave; row < rows; row += gridDim.x * 8) {
        f32x4 v[4]; float s = 0.f;
#pragma unroll
        for (int q = 0; q < 4; ++q) { const int col = q * 256 + lane * 4;
            if (part && row >= TL) {
                f32x4 sacc = (f32x4){0.f, 0.f, 0.f, 0.f};
                for (int sl = 0; sl < nsl; ++sl) sacc += *(const f32x4*)(part + ((size_t)sl * 256 + (row - TL)) * D + col);
                v[q] = *(const f32x4*)(xres_ctx + (size_t)(row - TL) * D + col) * ALPHA + *(const f32x4*)(gate_ctx + col) * sacc;
            } else v[q] = *(const f32x4*)(Z + (size_t)row * D + col);
            s += (v[q][0] + v[q][1]) + (v[q][2] + v[q][3]); }
        const float mu = wsum(s) * (1.f / 1024.f); float qq = 0.f;
#pragma unroll
        for (int q = 0; q < 4; ++q) { const f32x4 dl = v[q] - mu; qq += (dl[0] * dl[0] + dl[1] * dl[1]) + (dl[2] * dl[2] + dl[3] * dl[3]); }
        const float rstd = rsqrtf(wsum(qq) * (1.f / 1024.f) + LN_EPS);
        const float* mv = H ? modr_layer + (row < TL ? 0 : 6144) : nullptr;
#pragma unroll
        for (int q = 0; q < 4; ++q) { const int col = q * 256 + lane * 4; const f32x4 gg = *(const f32x4*)(g + col), bb = *(const f32x4*)(b + col);
            const f32x4 xn = (v[q] - mu) * rstd * gg + bb; *(f32x4*)(XO + (size_t)row * D + col) = xn;
            if (H) { const f32x4 sh = *(const f32x4*)(mv + sh_idx * 1024 + col), sc = *(const f32x4*)(mv + sc_idx * 1024 + col); const f32x4 h = xn * (sc + 1.0f) + sh;
                u32x2 w; w.x = pk2(h[0], h[1]); w.y = pk2(h[2], h[3]); *(u32x2*)(H + (size_t)row * D + col) = w; } }
    }
}
__device__ __forceinline__ void ag_rows(const Args& a, int b0, int nb, int s_lo, int s_hi) {
    if ((int)blockIdx.x < b0 || (int)blockIdx.x >= b0 + nb) return;
    const int lane = threadIdx.x & 63, wave = threadIdx.x >> 6;
    const bf16_t* P = (const bf16_t*)(a.ws + OFF_PBUF); bf16_t* AG = (bf16_t*)(a.ws + OFF_AG);
    const float* mu = a.in[12];
    const int gc = 2560 + lane * 2; const float m00 = mu[gc], m01 = mu[gc + 1], m10 = mu[2688 + gc], m11 = mu[2688 + gc + 1];
    const int hsel = lane >> 4;
    for (int st = s_lo + ((int)blockIdx.x - b0) * 8 + wave; st < s_hi; st += nb * 8) {
        const int m0 = st * 16, s0 = m0 < TL ? 0 : TL, len = m0 < TL ? TL : TC, t0 = m0 - s0;
        const int cc = 2688 + lane * 4;
        u32x2 x[32]; unsigned gx[18];
#pragma unroll
        for (int j = 0; j < 32; ++j) { const int t = t0 - 8 + j; x[j] = (t >= 0 && t < len) ? *(const u32x2*)(P + (size_t)(s0 + t) * PLD + cc) : (u32x2){0u, 0u}; }
#pragma unroll
        for (int j = 0; j < 18; ++j) { const int t = t0 - 1 + j; gx[j] = (t >= 0 && t < len) ? *(const unsigned*)(P + (size_t)(s0 + t) * PLD + gc) : 0u; }
#pragma unroll
        for (int r = 0; r < 16; ++r) {
            const int t = t0 + r, m = m0 + r;
            { const unsigned cu = gx[r + 1], pu = gx[r], nu = gx[r + 2];
              const float c0 = bf2f(cu & 0xffff), c1 = bf2f(cu >> 16), p0 = bf2f(pu & 0xffff), p1 = bf2f(pu >> 16), n0 = bf2f(nu & 0xffff), n1 = bf2f(nu >> 16);
              const float x0 = c0 + (p0 - c0) * m00 + (n0 - c0) * m10, x1 = c1 + (p1 - c1) * m01 + (n1 - c1) * m11;
              *(unsigned*)(AG + (size_t)m * 384 + lane * 2) = pk2(sigm(x0), sigm(x1)); }
            f32x4 sw = (f32x4){0.f, 0.f, 0.f, 0.f}, acc = (f32x4){0.f, 0.f, 0.f, 0.f};
#pragma unroll
            for (int lv = 0; lv < 4; ++lv) { const int hw = 1 << lv, hp = hw >> 1;
#pragma unroll
                for (int j = -hw; j < hw; ++j) if (lv == 0 || j < -hp || j >= hp) { const u32x2 w = x[r + 8 + j]; acc += (f32x4){bf2f(w.x & 0xffff), bf2f(w.x >> 16), bf2f(w.y & 0xffff), bf2f(w.y >> 16)}; }
                if (hsel == lv) sw = acc; }
            const int half = 1 << hsel; const int lo = max(t - half, 0), hi = min(t + half, len); const float inv = rcp_((float)(hi - lo));
            const u32x2 cw = x[r + 8];
            u32x2 o; o.x = pk2(sw[0] * inv - bf2f(cw.x & 0xffff), sw[1] * inv - bf2f(cw.x >> 16)); o.y = pk2(sw[2] * inv - bf2f(cw.y & 0xffff), sw[3] * inv - bf2f(cw.y >> 16));
            *(u32x2*)(AG + (size_t)m * 384 + 128 + lane * 4) = o;
        }
    }
}
__device__ __forceinline__ void scan_pos(int d, int u, int& m, bool& hp, bool& hn) {
    if (u < TC) { const int t = d ? (TC - 1 - u) : u; m = TL + t; hp = t > 0; hn = t < TC - 1; }
    else { const int t = d ? (TL - 1 - (u - TC)) : (u - TC); m = t; hp = t > 0; hn = t < TL - 1; }
}
__device__ __forceinline__ int lane_id() { return __builtin_amdgcn_mbcnt_hi(~0u, __builtin_amdgcn_mbcnt_lo(~0u, 0u)); }
constexpr int SH_OFF = 8 * WAVE_LDS, SH_W2 = SH_OFF, SH_A2 = SH_OFF + 9216, SH_CST = SH_OFF + 18432, SH_MU = SH_CST + 1280;
__device__ __forceinline__ void scan_setup(const Args& a, int h, int d, unsigned char* lds) {
    const int tid = threadIdx.x;
    const bf16_t* wb = (const bf16_t*)a.out;
    const bf16_t* w2 = wb + WO_W2T / 2 + (size_t)(d * DA + h * 64) * 64; const bf16_t* a2 = wb + WO_A2T / 2 + (size_t)(d * DA + h * 64) * 64;
    { const int n = tid >> 3, c8 = tid & 7; *(u32x4*)(lds + SH_W2 + (n * 72 + c8 * 8) * 2) = *(const u32x4*)(w2 + n * 64 + c8 * 8); *(u32x4*)(lds + SH_A2 + (n * 72 + c8 * 8) * 2) = *(const u32x4*)(a2 + n * 64 + c8 * 8); }
    if (tid < 320) { const int which = tid >> 6, ch = tid & 63; float v;
        if (which == 0) v = a.in[13][d * DA + h * 64 + ch]; else if (which == 1) v = a.in[15][d * DA + h * 64 + ch]; else if (which == 2) v = a.in[18][h * 64 + ch]; else if (which == 3) v = a.in[19][h * 64 + ch]; else v = a.in[20][h * 64 + ch];
        ((float*)(lds + SH_CST))[which * 64 + (ch & 15) * 4 + (ch >> 4)] = v; }
    for (int i = tid; i < 640; i += 512) { const int cg = i >> 7, sel = (i >> 6) & 1, ch = i & 63;
        const int col = (cg == 0 ? h * 64 : cg == 1 ? 768 + h * 64 : cg == 2 ? 1536 + h * 64 : cg == 3 ? 2304 + d * 64 : 2432 + d * 64) + ch;
        ((float*)(lds + SH_MU))[i] = a.in[12][sel * 2688 + col]; }
    __syncthreads();
}
#define SB __builtin_amdgcn_sched_barrier(0)
struct Raw { unsigned short v[5][10]; };
#ifndef PFA
#define PFA 3
#endif
__device__ __forceinline__ void prep_geom(int d, int u0, int& mlo, int& seq_first, int& seq_last) {
    const bool isctx = u0 < TC;
    seq_first = isctx ? TL : 0; seq_last = isctx ? TL + TC - 1 : TL - 1;
    const int mu0 = isctx ? TL + (d ? TC - 1 - u0 : u0) : (d ? TL - 1 - (u0 - TC) : u0 - TC);
    mlo = d ? mu0 - 7 : mu0;
}
template <int C0, int C1>
__device__ __forceinline__ void prep_load(const bf16_t* __restrict__ P, int h, int d, int u0, Raw& raw) {
    const int lane = lane_id();
    int mlo, seq_first, seq_last; prep_geom(d, u0, mlo, seq_first, seq_last);
    const int cols[5] = {h * 64 + lane, 768 + h * 64 + lane, 1536 + h * 64 + lane, 2304 + d * 64 + lane, 2432 + d * 64 + lane};
#pragma unroll
    for (int j = 0; j < 10; ++j) { const int row = min(max(mlo - 1 + j, seq_first), seq_last); const bf16_t* rp = P + (size_t)row * PLD;
#pragma unroll
        for (int c = C0; c < C1; ++c) raw.v[c][j] = rp[cols[c]]; }
}
template <bool COEF>
__device__ __forceinline__ void scan_prep(const Raw& raw, int h, int d, int u0, float* L, bf16_t* At, const unsigned char* lds, float* coef_d) {
    __builtin_amdgcn_s_setprio(3);
    const int lane = lane_id(); const int l16 = lane & 15, quad = lane >> 4;
    int mlo, seq_first, seq_last; prep_geom(d, u0, mlo, seq_first, seq_last);
    const bool okp = (mlo - 1 >= seq_first), okn = (mlo + 8 <= seq_last);
    const float* mul = (const float*)(lds + SH_MU);
#pragma unroll
    for (int c = 0; c < 5; ++c) {
        const float m0 = mul[(c * 2 + 0) * 64 + lane], m1 = mul[(c * 2 + 1) * 64 + lane];
#pragma unroll
        for (int jj = 1; jj <= 8; ++jj) {
            const int tt = d ? 8 - jj : jj - 1;
            const float cur = bf2f(raw.v[c][jj]); float pv = bf2f(raw.v[c][jj - 1]), nx = bf2f(raw.v[c][jj + 1]);
            if (jj == 1) pv = okp ? pv : 0.f;
            if (jj == 8) nx = okn ? nx : 0.f;
            const float mx = cur + (pv - cur) * m0 + (nx - cur) * m1;
            if (c == 0) L[(tt * 6 + 4) * 64 + (lane & 15) * 4 + (lane >> 4)] = mx;
            else if (c == 1) L[(tt * 6 + 2) * 64 + (lane & 15) * 4 + (lane >> 4)] = mx;
            else if (c == 2) L[(tt * 6 + 5) * 64 + lane] = mx;
            else if (c == 3) { const float e2 = __expf(2.f * mx); const bf16_t tb = (bf16_t)f2bf(1.f - 2.f * rcp_(e2 + 1.f)); At[tt * 72 + lane] = tb; At[(tt + 8) * 72 + lane] = tb; }
            else { const bf16_t ab = (bf16_t)f2bf(mx); At[16 * 72 + tt * 72 + lane] = ab; At[16 * 72 + (tt + 8) * 72 + lane] = ab; }
        }
    }
    if (lane < 8) *(int*)(At + lane * 72 + 64) = d ? mlo + 7 - lane : mlo + lane;
    wave_sync();
    f32x4 accw[4], acca[4];
#pragma unroll
    for (int nt = 0; nt < 4; ++nt) { accw[nt] = (f32x4){0.f, 0.f, 0.f, 0.f}; acca[nt] = (f32x4){0.f, 0.f, 0.f, 0.f}; }
    const bf16_t* W2l = (const bf16_t*)(lds + SH_W2); const bf16_t* A2l = (const bf16_t*)(lds + SH_A2);
#pragma unroll
    for (int ks = 0; ks < 2; ++ks) {
        const bf16x8 aw = *(const bf16x8*)(At + l16 * 72 + ks * 32 + quad * 8), aa = *(const bf16x8*)(At + 16 * 72 + l16 * 72 + ks * 32 + quad * 8);
#pragma unroll
        for (int nt = 0; nt < 4; ++nt) {
            const bf16x8 bw = *(const bf16x8*)(W2l + (nt * 16 + l16) * 72 + ks * 32 + quad * 8), ba = *(const bf16x8*)(A2l + (nt * 16 + l16) * 72 + ks * 32 + quad * 8);
            accw[nt] = __builtin_amdgcn_mfma_f32_16x16x32_bf16(aw, bw, accw[nt], 0, 0, 0); acca[nt] = __builtin_amdgcn_mfma_f32_16x16x32_bf16(aa, ba, acca[nt], 0, 0, 0);
        }
    }
    const float* cst = (const float*)(lds + SH_CST);
    const bool hi = quad >= 2; const int ntb = hi ? 2 : 0;
    f32x4 aw[2], aa[2];
    aw[0] = hi ? accw[2] : accw[0]; aw[1] = hi ? accw[3] : accw[1]; aa[0] = hi ? acca[2] : acca[0]; aa[1] = hi ? acca[3] : acca[1];
#pragma unroll
    for (int j = 0; j < 4; ++j) {
        SB;
        const int o2 = l16 * 4 + ntb;
        const f32x2 cw0 = *(const f32x2*)(cst + o2), ca0 = *(const f32x2*)(cst + 64 + o2), ckk = *(const f32x2*)(cst + 128 + o2), cka = *(const f32x2*)(cst + 192 + o2), crk = *(const f32x2*)(cst + 256 + o2);
        const int tok = (quad & 1) * 4 + j;
        const f32x2 kv = *(const f32x2*)(L + (tok * 6 + 2) * 64 + o2), rv = *(const f32x2*)(L + (tok * 6 + 4) * 64 + o2);
        const f32x2 kkv = kv * ckk;
        float ss = xsum32(sum16(kkv[0] * kkv[0] + kkv[1] * kkv[1]));
        const float inv = __builtin_amdgcn_rsqf(fmaxf(ss, 1e-24f));
        float cs = 0.f; f32x2 o_w, o_b, o_kd, o_kk;
#pragma unroll
        for (int e = 0; e < 2; ++e) {
            o_w[e] = __expf(-0.60653066f * sigm(cw0[e] + aw[e][j]));
            const float av = sigm(ca0[e] + aa[e][j]);
            o_kk[e] = kkv[e] * inv; o_b[e] = o_kk[e] * av; o_kd[e] = kv[e] * (1.f + (av - 1.f) * cka[e]);
            if (COEF) cs += rv[e] * o_kd[e] * crk[e];
        }
        { const int n0 = ntb * 16 + l16;
          L[(tok * 6 + 0) * 64 + n0] = o_w[0]; L[(tok * 6 + 0) * 64 + n0 + 16] = o_w[1]; L[(tok * 6 + 1) * 64 + n0] = o_b[0]; L[(tok * 6 + 1) * 64 + n0 + 16] = o_b[1];
          L[(tok * 6 + 2) * 64 + n0] = o_kd[0]; L[(tok * 6 + 2) * 64 + n0 + 16] = o_kd[1]; }
        *(f32x2*)(L + (tok * 6 + 3) * 64 + o2) = o_kk;
        if (COEF) { cs = xsum32(sum16(cs)); if (lane < 32 && l16 == 0) { const int m = *(const int*)(At + tok * 72 + 64); coef_d[(size_t)m * 12 + h] = cs; } }
    }
    wave_sync();
    __builtin_amdgcn_s_setprio(0);
}
#define FMAC_K(acc, X, Sv, K) asm volatile("v_fmac_f32_dpp %0, %1, %2 row_newbcast:" #K " row_mask:0xf bank_mask:0xf" : "+v"(acc) : "v"(X), "v"(Sv))
#define MULIP_K(Sv, X, K) asm volatile("v_mul_f32_dpp %0, %1, %0 row_newbcast:" #K " row_mask:0xf bank_mask:0xf" : "+v"(Sv) : "v"(X))
#define K16(M) M(0) M(1) M(2) M(3) M(4) M(5) M(6) M(7) M(8) M(9) M(10) M(11) M(12) M(13) M(14) M(15)
#ifndef DEPC_
#define DEPC_ 3
#endif
#ifndef DEPA_
#define DEPA_ 2
#endif
struct TokVec { f32x4 kk, r; float v; };
__device__ __forceinline__ void tok_load(TokVec& t, const float* V, int lane_unused, bool need_r) {
    const int lane = lane_id(); const int o = (lane & 15) * 4;
    t.kk = *(const f32x4*)(V + 192 + o);
    if (need_r) t.r = *(const f32x4*)(V + 256 + o);
    t.v = V[320 + lane];
}
#define F2(v, i) ((f32x2){(v)[2 * (i)], (v)[2 * (i) + 1]})
#define SPn(n) SP[(n) >> 1][(n) & 1]
#define SQn(n) SQ[(n) >> 1][(n) & 1]
#define SSn(n) S[(n) >> 1][(n) & 1]
#define A_DOT(k) FMAC_K(ap0, kk0, SPn(k), k); FMAC_K(ap1, kk1, SPn(16 + k), k); FMAC_K(ap2, kk2, SPn(32 + k), k); FMAC_K(ap3, kk3, SPn(48 + k), k); \
                 FMAC_K(aq0, kk0, SQn(k), k); FMAC_K(aq1, kk1, SQn(16 + k), k); FMAC_K(aq2, kk2, SQn(32 + k), k); FMAC_K(aq3, kk3, SQn(48 + k), k);
__device__ __forceinline__ void scan_passA(const Args& a, unsigned char* lds) {
    const int lane = threadIdx.x & 63, wave = __builtin_amdgcn_readfirstlane(threadIdx.x >> 6);
    if ((int)blockIdx.x * 8 >= 24 * NC) return;
    const int item = blockIdx.x * 8 + wave, hd = (blockIdx.x * 8) / NC, cidx = item % NC, h = hd >> 1, d = hd & 1;
    scan_setup(a, h, d, lds);
    float* L = (float*)(lds + wave * WAVE_LDS); bf16_t* At = (bf16_t*)(lds + wave * WAVE_LDS + NS * 6 * 64 * 4);
    const bf16_t* P = (const bf16_t*)(a.ws + OFF_PBUF);
    f32x2 SP[32], SQ[32];
#pragma unroll
    for (int q = 0; q < 32; ++q) { SP[q] = (f32x2){(2 * q == lane) ? 1.f : 0.f, (2 * q + 1 == lane) ? 1.f : 0.f}; SQ[q] = (f32x2){0.f, 0.f}; }
    Raw raw; prep_load<0, PFA>(P, h, d, cidx * CH, raw);
#pragma unroll 1
    for (int g = 0; g < CH / NS; ++g) {
        prep_load<PFA, 5>(P, h, d, cidx * CH + g * NS, raw);
        scan_prep<false>(raw, h, d, cidx * CH + g * NS, L, At, lds, nullptr);
        prep_load<0, PFA>(P, h, d, cidx * CH + min(g + 1, CH / NS - 1) * NS, raw);
#pragma unroll 1
        for (int tt = 0; tt < NS; ++tt) {
            const float* V = L + tt * 384;
            TokVec TA; tok_load(TA, V, lane, false);
            constexpr int DEPA = DEPA_;
            f32x4 ub[DEPA + 1][3];
#define A_ISSUE(qi) { ub[(qi) % (DEPA + 1)][0] = *(const f32x4*)(V + (qi) * 4); ub[(qi) % (DEPA + 1)][1] = *(const f32x4*)(V + 64 + (qi) * 4); ub[(qi) % (DEPA + 1)][2] = *(const f32x4*)(V + 128 + (qi) * 4); }
#pragma unroll
            for (int qi = 0; qi < DEPA; ++qi) A_ISSUE(qi)
            SB;
            const float kk0 = TA.kk[0], kk1 = TA.kk[1], kk2 = TA.kk[2], kk3 = TA.kk[3], vv = TA.v;
            float ap0 = 0.f, ap1 = 0.f, ap2 = 0.f, ap3 = 0.f, aq0 = 0.f, aq1 = 0.f, aq2 = 0.f, aq3 = 0.f;
            K16(A_DOT)
            const float sap = -((ap0 + ap1) + (ap2 + ap3)), saq = -((aq0 + aq1) + (aq2 + aq3));
            const f32x2 sap2 = (f32x2){sap, sap}, saq2 = (f32x2){saq, saq}, v2 = (f32x2){vv, vv};
#pragma unroll
            for (int q = 0; q < 16; ++q) {
                if (q + DEPA < 16) A_ISSUE(q + DEPA)
                SB;
                { const f32x4 w4 = ub[q % (DEPA + 1)][0], b4 = ub[q % (DEPA + 1)][1], d4 = ub[q % (DEPA + 1)][2];
                    SP[2 * q] = SP[2 * q] * F2(w4, 0) + sap2 * F2(b4, 0); SP[2 * q + 1] = SP[2 * q + 1] * F2(w4, 1) + sap2 * F2(b4, 1);
                    SQ[2 * q] = SQ[2 * q] * F2(w4, 0) + (saq2 * F2(b4, 0) + v2 * F2(d4, 0)); SQ[2 * q + 1] = SQ[2 * q + 1] * F2(w4, 1) + (saq2 * F2(b4, 1) + v2 * F2(d4, 1)); }
                SB;
            }
        }
        wave_sync();
    }
    float* PQ = (float*)(a.ws + OFF_PQ) + (size_t)item * 8192; const int lane2 = lane_id();
#pragma unroll
    for (int q = 0; q < 16; ++q) { *(f32x4*)(PQ + lane2 * 64 + q * 4) = (f32x4){SP[2 * q][0], SP[2 * q][1], SP[2 * q + 1][0], SP[2 * q + 1][1]};
        *(f32x4*)(PQ + 4096 + lane2 * 64 + q * 4) = (f32x4){SQ[2 * q][0], SQ[2 * q][1], SQ[2 * q + 1][0], SQ[2 * q + 1][1]}; }
}
__device__ __forceinline__ void scan_passB(const Args& a, unsigned char* lds) {
    const int tid = threadIdx.x, b = blockIdx.x, hd = b >> 3, rg = b & 7, il = tid >> 6, n = tid & 63, i = rg * 8 + il;
    float* Sl = (float*)lds;
    float* Pl = Sl + 1024;
    float* base = (float*)(a.ws + OFF_PQ) + (size_t)hd * NC * 8192;
    Sl[tid] = 0.f;
    f32x4 p0 = *(const f32x4*)(base + tid * 8), p1 = *(const f32x4*)(base + tid * 8 + 4);
    *(f32x4*)(Pl + tid * 8) = p0; *(f32x4*)(Pl + tid * 8 + 4) = p1;
    float q = base[4096 + i * 64 + n], qn = 0.f;
    if (NC > 2) { p0 = *(const f32x4*)(base + 8192 + tid * 8); p1 = *(const f32x4*)(base + 8192 + tid * 8 + 4); qn = base[8192 + 4096 + i * 64 + n]; }
    __syncthreads();
    for (int c = 0; c < NC - 1; ++c) {
        const int cur = c & 1;
        const float* Sc = Sl + cur * 512 + il * 64; const float* Pc = Pl + cur * 4096 + n;
        float acc0 = q, acc1 = 0.f;
#pragma unroll
        for (int m = 0; m < 64; m += 4) { const f32x4 s4 = *(const f32x4*)(Sc + m);
            acc0 += s4[0] * Pc[(m + 0) * 64]; acc1 += s4[1] * Pc[(m + 1) * 64]; acc0 += s4[2] * Pc[(m + 2) * 64]; acc1 += s4[3] * Pc[(m + 3) * 64]; }
        const float acc = acc0 + acc1;
        Sl[(cur ^ 1) * 512 + il * 64 + n] = acc; base[(size_t)c * 8192 + 4096 + i * 64 + n] = acc;
        *(f32x4*)(Pl + (cur ^ 1) * 4096 + tid * 8) = p0; *(f32x4*)(Pl + (cur ^ 1) * 4096 + tid * 8 + 4) = p1; q = qn;
        if (c + 2 < NC - 1) { const float* nb = base + (size_t)(c + 2) * 8192; p0 = *(const f32x4*)(nb + tid * 8); p1 = *(const f32x4*)(nb + tid * 8 + 4); qn = nb[4096 + i * 64 + n]; }
        __syncthreads();
    }
}
#define C_DOT(k) FMAC_K(aq0, kk0, SSn(k), k); FMAC_K(aq1, kk1, SSn(16 + k), k); FMAC_K(aq2, kk2, SSn(32 + k), k); FMAC_K(aq3, kk3, SSn(48 + k), k);
#define C_Y(k) FMAC_K(ya0, r0, SSn(k), k); FMAC_K(ya1, r1, SSn(16 + k), k); FMAC_K(ya2, r2, SSn(32 + k), k); FMAC_K(ya3, r3, SSn(48 + k), k);
__device__ __forceinline__ void scan_passC(const Args& a, unsigned char* lds) {
    const int lane = threadIdx.x & 63, wave = __builtin_amdgcn_readfirstlane(threadIdx.x >> 6);
    if ((int)blockIdx.x * 8 >= 24 * NC) return;
    const int item = blockIdx.x * 8 + wave, hd = (blockIdx.x * 8) / NC, cidx = item % NC, h = hd >> 1, d = hd & 1;
    scan_setup(a, h, d, lds);
    float* L = (float*)(lds + wave * WAVE_LDS); bf16_t* At = (bf16_t*)(lds + wave * WAVE_LDS + NS * 6 * 64 * 4);
    const bf16_t* P = (const bf16_t*)(a.ws + OFF_PBUF);
    bf16_t* Y = (bf16_t*)(a.ws + OFF_Y) + (size_t)d * T * DA; float* coef_d = (float*)(a.ws + OFF_COEF) + (size_t)d * T * 12;
    f32x2 S[32];
    if (cidx > 0) { const float* S0 = (const float*)(a.ws + OFF_PQ) + (size_t)(item - 1) * 8192 + 4096 + lane * 64;
#pragma unroll
        for (int q = 0; q < 16; ++q) { const f32x4 s4 = *(const f32x4*)(S0 + q * 4); S[2 * q] = (f32x2){s4[0], s4[1]}; S[2 * q + 1] = (f32x2){s4[2], s4[3]}; } }
    else {
#pragma unroll
        for (int q = 0; q < 32; ++q) S[q] = (f32x2){0.f, 0.f}; }
#pragma unroll 1
    for (int g = 0; g < CH / NS; ++g) {
        const int u0 = cidx * CH + g * NS;
        { Raw raw; prep_load<0, 5>(P, h, d, u0, raw); scan_prep<true>(raw, h, d, u0, L, At, lds, coef_d); }
#pragma unroll 1
        for (int tt = 0; tt < NS; ++tt) {
            const float* V = L + tt * 384;
            TokVec TA; tok_load(TA, V, lane, true);
            const int m0 = *(const int*)(At + tt * 72 + 64);
            constexpr int DEP = DEPC_;
            f32x4 ub[DEP + 1][2][3];
#define C_ISSUE(bb) { _Pragma("unroll") for (int qq = 0; qq < 2; ++qq) { const int q_ = (bb) * 2 + qq; ub[(bb) % (DEP + 1)][qq][0] = *(const f32x4*)(V + q_ * 4); ub[(bb) % (DEP + 1)][qq][1] = *(const f32x4*)(V + 64 + q_ * 4); ub[(bb) % (DEP + 1)][qq][2] = *(const f32x4*)(V + 128 + q_ * 4); } }
#pragma unroll
            for (int bb = 0; bb < DEP; ++bb) C_ISSUE(bb)
            SB;
            const float kk0 = TA.kk[0], kk1 = TA.kk[1], kk2 = TA.kk[2], kk3 = TA.kk[3], r0 = TA.r[0], r1 = TA.r[1], r2 = TA.r[2], r3 = TA.r[3], vv = TA.v;
            float aq0 = 0.f, aq1 = 0.f, aq2 = 0.f, aq3 = 0.f;
            K16(C_DOT)
            const float sa = -((aq0 + aq1) + (aq2 + aq3));
            const f32x2 sa2 = (f32x2){sa, sa}, v2 = (f32x2){vv, vv};
#pragma unroll
            for (int b = 0; b < 8; ++b) {
                if (b + DEP < 8) C_ISSUE(b + DEP)
                SB;
#pragma unroll
                for (int qq = 0; qq < 2; ++qq) { const int q = b * 2 + qq; const f32x4 w4 = ub[b % (DEP + 1)][qq][0], b4 = ub[b % (DEP + 1)][qq][1], d4 = ub[b % (DEP + 1)][qq][2];
                    S[2 * q] = S[2 * q] * F2(w4, 0) + (sa2 * F2(b4, 0) + v2 * F2(d4, 0)); S[2 * q + 1] = S[2 * q + 1] * F2(w4, 1) + (sa2 * F2(b4, 1) + v2 * F2(d4, 1)); }
                SB;
            }
            float ya0 = 0.f, ya1 = 0.f, ya2 = 0.f, ya3 = 0.f;
            K16(C_Y)
            { const int ln = lane_id(); Y[(size_t)m0 * DA + h * 64 + ln] = (bf16_t)f2bf((ya0 + ya1) + (ya2 + ya3)); }
        }
        wave_sync();
    }
}
__device__ __forceinline__ void readout_rows(const Args& a) {
    const int lane = threadIdx.x & 63, wave = threadIdx.x >> 6, hg = lane >> 4, sub = lane & 15;
    const bf16_t* P = (const bf16_t*)(a.ws + OFF_PBUF); const bf16_t* Y = (const bf16_t*)(a.ws + OFF_Y); const float* CO = (const float*)(a.ws + OFF_COEF);
    bf16_t* H = (bf16_t*)(a.ws + OFF_HBUF);
#pragma unroll 2
    for (int m = blockIdx.x * 8 + wave; m < T; m += gridDim.x * 8) {
        const int s0 = m < TL ? 0 : TL, len = m < TL ? TL : TC, t = m - s0; const bool hp = t > 0, hn = t < len - 1;
        const bf16_t* row = P + (size_t)m * PLD;
#pragma unroll
        for (int hq = 0; hq < 3; ++hq) {
            const int h = hq * 4 + hg, ch = h * 64 + sub * 4, vc = 1536 + ch;
            const u32x2 y0 = *(const u32x2*)(Y + (size_t)m * DA + ch), y1 = *(const u32x2*)(Y + (size_t)(T + m) * DA + ch);
            const u32x2 pc = *(const u32x2*)(row + vc); const u32x2 pp = hp ? *(const u32x2*)(row + vc - PLD) : (u32x2){0u, 0u}; const u32x2 pn = hn ? *(const u32x2*)(row + vc + PLD) : (u32x2){0u, 0u};
            const u32x2 gw = *(const u32x2*)(H + (size_t)m * D + ch);
            const f32x4 lg = *(const f32x4*)(a.in[21] + ch), lb = *(const f32x4*)(a.in[22] + ch), m0 = *(const f32x4*)(a.in[12] + vc), m1 = *(const f32x4*)(a.in[12] + 2688 + vc);
            const float coef = CO[(size_t)m * 12 + h] + CO[(size_t)(T + m) * 12 + h];
            float y[4] = {bf2f(y0.x & 0xffff) + bf2f(y1.x & 0xffff), bf2f(y0.x >> 16) + bf2f(y1.x >> 16), bf2f(y0.y & 0xffff) + bf2f(y1.y & 0xffff), bf2f(y0.y >> 16) + bf2f(y1.y >> 16)};
            const float cu[4] = {bf2f(pc.x & 0xffff), bf2f(pc.x >> 16), bf2f(pc.y & 0xffff), bf2f(pc.y >> 16)};
            const float pv[4] = {bf2f(pp.x & 0xffff), bf2f(pp.x >> 16), bf2f(pp.y & 0xffff), bf2f(pp.y >> 16)};
            const float nx[4] = {bf2f(pn.x & 0xffff), bf2f(pn.x >> 16), bf2f(pn.y & 0xffff), bf2f(pn.y >> 16)};
            const float g[4] = {bf2f(gw.x & 0xffff), bf2f(gw.x >> 16), bf2f(gw.y & 0xffff), bf2f(gw.y >> 16)};
            const float mu = sum16((y[0] + y[1]) + (y[2] + y[3])) * (1.f / 64.f);
            float q = 0.f;
#pragma unroll
            for (int e = 0; e < 4; ++e) { y[e] -= mu; q += y[e] * y[e]; }
            const float rstd = rsqrtf(sum16(q) * (1.f / 64.f) + GN_EPS);
            float o[4];
#pragma unroll
            for (int e = 0; e < 4; ++e) { const float v = cu[e] + (pv[e] - cu[e]) * m0[e] + (nx[e] - cu[e]) * m1[e]; o[e] = (y[e] * rstd * lg[e] + lb[e] + coef * v) * g[e]; }
            u32x2 w; w.x = pk2(o[0], o[1]); w.y = pk2(o[2], o[3]);
            *(u32x2*)(H + (size_t)m * D + ch) = w;
        }
    }
}
constexpr int NA_KC = 0, NA_VC = 36864, NA_RPB = 36864 + 33792;
template <int HALF, int KSTRIDE, int VSTRIDE>
__device__ __forceinline__ void natten_half(const bf16_t* __restrict__ kbase, const bf16_t* __restrict__ vbase, const float* __restrict__ rpbh, const bf16x8 q0, const bf16x8 q1,
                                            int quad, int kr0, int kc0, int sc, f32x4 (&o)[4], float& mrun, float& lrun) {
#define KOFF(kt) (HALF ? (kt) * 16 : (((kt) >> 1) * 64 + ((kt) & 1) * 16))
    f32x4 s[16];
    {
        bf16x8 kf[16][2];
        const bf16_t* kp = kbase;
#pragma unroll
        for (int kt = 0; kt < 16; ++kt) { kf[kt][0] = *(const bf16x8*)kp; kf[kt][1] = *(const bf16x8*)(kp + 32); kp += (size_t)(KOFF(kt + 1) - KOFF(kt)) * KSTRIDE; }
        SB;
#pragma unroll
        for (int kt = 0; kt < 16; ++kt) { f32x4 z = (f32x4){0.f, 0.f, 0.f, 0.f};
            z = __builtin_amdgcn_mfma_f32_16x16x32_bf16(kf[kt][0], q0, z, 0, 0, 0); s[kt] = __builtin_amdgcn_mfma_f32_16x16x32_bf16(kf[kt][1], q1, z, 0, 0, 0); }
        SB;
    }
    u32x2 vf[8][4][2];
#pragma unroll
    for (int kp2 = 0; kp2 < 8; ++kp2)
#pragma unroll
        for (int dt = 0; dt < 4; ++dt) { const bf16_t* vp = vbase + (size_t)dt * 16 * VSTRIDE; vf[kp2][dt][0] = *(const u32x2*)(vp + KOFF(2 * kp2)); vf[kp2][dt][1] = *(const u32x2*)(vp + KOFF(2 * kp2 + 1)); }
    SB;
    float mx = -1e30f;
#pragma unroll
    for (int kt = 0; kt < 16; ++kt)
#pragma unroll
        for (int j = 0; j < 4; ++j) {
            float v = s[kt][j] * 0.125f;
            if (HALF == 0) { const int kc = kc0 + (kt & 1) * 16 + j; const bool ok = (kc >= sc) && (kc < sc + 16);
                if (ok) v += rpbh[(kr0 + (kt >> 1)) * 31 + kc]; else v = -1e30f; }
            s[kt][j] = v; mx = fmaxf(mx, v);
        }
    mx = fmaxf(mx, __shfl_xor(mx, 16)); mx = fmaxf(mx, __shfl_xor(mx, 32));
    const float mnew = fmaxf(mrun, mx), resc = __expf(mrun - mnew);
    float sm = 0.f;
#pragma unroll
    for (int kt = 0; kt < 16; ++kt)
#pragma unroll
        for (int j = 0; j < 4; ++j) { const float e = __expf(s[kt][j] - mnew); s[kt][j] = e; sm += e; }
    sm += __shfl_xor(sm, 16); sm += __shfl_xor(sm, 32);
    lrun = lrun * resc + sm; mrun = mnew;
#pragma unroll
    for (int j = 0; j < 4; ++j) { const float rj = __shfl(resc, quad * 4 + j);
#pragma unroll
        for (int dt = 0; dt < 4; ++dt) o[dt][j] *= rj; }
    SB;
#pragma unroll
    for (int kp2 = 0; kp2 < 8; ++kp2) {
        const int ka = 2 * kp2, kb = 2 * kp2 + 1;
        u32x4 pw; pw.x = pk2(s[ka][0], s[ka][1]); pw.y = pk2(s[ka][2], s[ka][3]); pw.z = pk2(s[kb][0], s[kb][1]); pw.w = pk2(s[kb][2], s[kb][3]);
        const bf16x8 pa = __builtin_bit_cast(bf16x8, pw);
#pragma unroll
        for (int dt = 0; dt < 4; ++dt) {
            u32x4 vw; vw.x = vf[kp2][dt][0].x; vw.y = vf[kp2][dt][0].y; vw.z = vf[kp2][dt][1].x; vw.w = vf[kp2][dt][1].y;
            o[dt] = __builtin_amdgcn_mfma_f32_16x16x32_bf16(pa, __builtin_bit_cast(bf16x8, vw), o[dt], 0, 0, 0);
        }
    }
    SB;
#undef KOFF
}
#define NA_BLOCK(t, BIAS) { \
    f32x4 sA = (f32x4){0.f, 0.f, 0.f, 0.f}, sB = (f32x4){0.f, 0.f, 0.f, 0.f}; \
    sA = __builtin_amdgcn_mfma_f32_16x16x32_bf16(kA0, qa[t], sA, 0, 0, 0); sA = __builtin_amdgcn_mfma_f32_16x16x32_bf16(kA1, qb[t], sA, 0, 0, 0); \
    sB = __builtin_amdgcn_mfma_f32_16x16x32_bf16(kB0, qa[t], sB, 0, 0, 0); sB = __builtin_amdgcn_mfma_f32_16x16x32_bf16(kB1, qb[t], sB, 0, 0, 0); \
    float v_[8]; \
    _Pragma("unroll") for (int j = 0; j < 4; ++j) { v_[j] = sA[j] * 0.125f; v_[4 + j] = sB[j] * 0.125f; } \
    if (BIAS) { const float* rb_ = rpbl + (kr - (r0 + t) + 7) * 31 + (15 - cq); \
        _Pragma("unroll") for (int j = 0; j < 4; ++j) { const int kcA = cbase + quad * 4 + j, kcB = kcA + 16; \
            v_[j] = (kcA >= sc && kcA < sc + 16) ? v_[j] + rb_[kcA] : -1e30f; v_[4 + j] = (kcB >= sc && kcB < sc + 16) ? v_[4 + j] + rb_[kcB] : -1e30f; } } \
    float bm_ = fmaxf(fmaxf(fmaxf(v_[0], v_[1]), fmaxf(v_[2], v_[3])), fmaxf(fmaxf(v_[4], v_[5]), fmaxf(v_[6], v_[7]))); \
    if (__any(bm_ > mref[t] + 8.f)) { bm_ = xmax32(xmax16(bm_));     \
        const bool need_ = bm_ > mref[t] + 8.f; const float mn_ = need_ ? bm_ : mref[t]; const float rs_ = __expf(mref[t] - mn_); lsum[t] *= rs_; mref[t] = mn_; \
        _Pragma("unroll") for (int j = 0; j < 4; ++j) { const float rj_ = __shfl(rs_, quad * 4 + j); \
            _Pragma("unroll") for (int dt = 0; dt < 4; ++dt) o[t][dt][j] *= rj_; } } \
    float ps_ = 0.f; \
    _Pragma("unroll") for (int i = 0; i < 8; ++i) { v_[i] = __expf(v_[i] - mref[t]); ps_ += v_[i]; } \
    lsum[t] += ps_;     \
    u32x4 pw_; pw_.x = pk2(v_[0], v_[1]); pw_.y = pk2(v_[2], v_[3]); pw_.z = pk2(v_[4], v_[5]); pw_.w = pk2(v_[6], v_[7]); \
    const bf16x8 pa_ = __builtin_bit_cast(bf16x8, pw_); \
    _Pragma("unroll") for (int dt = 0; dt < 4; ++dt) o[t][dt] = __builtin_amdgcn_mfma_f32_16x16x32_bf16(pa_, vfr[dt], o[t][dt], 0, 0, 0); }
__device__ __forceinline__ void natten(const Args& a, unsigned char* lds) {
    const int tid = threadIdx.x, lane = tid & 63, wave = __builtin_amdgcn_readfirstlane(tid >> 6), l16 = lane & 15, quad = lane >> 4;
    const bf16_t* QK = (const bf16_t*)(a.ws + OFF_QK); const bf16_t* Vt = (const bf16_t*)(a.ws + OFF_VT); bf16_t* O = (bf16_t*)(a.ws + OFF_HBUF);
    const int h = blockIdx.x & 15, rb = blockIdx.x >> 4;
    bf16_t* Kc = (bf16_t*)(lds + NA_KC); bf16_t* Vc = (bf16_t*)(lds + NA_VC); float* rpbl = (float*)(lds + NA_RPB);
    for (int i = tid; i < 2048; i += 512) { const int t = i >> 3, c8 = i & 7; *(u32x4*)(Kc + t * 72 + c8 * 8) = *(const u32x4*)(QK + (size_t)(TL + t) * 2048 + 1024 + h * 64 + c8 * 8);
        const int dd = i >> 5, c32 = i & 31; *(u32x4*)(Vc + dd * 264 + c32 * 8) = *(const u32x4*)(Vt + (size_t)(h * 64 + dd) * T + TL + c32 * 8); }
    if (tid < 465) rpbl[tid] = a.in[27][h * 465 + tid];
    __syncthreads();
#pragma unroll 1
    for (int jt = wave; jt < 16; jt += 8) {
        const int cgi = jt & 3, r0 = (rb * 4 + (jt >> 2)) * 4, c0 = cgi * 16, cbase = min(max(c0 - 8, 0), 32);
        const int cq = c0 + l16, sc = min(max(cq - 8, 0), 48);
        bf16x8 qa[4], qb[4];
#pragma unroll
        for (int t = 0; t < 4; ++t) { const bf16_t* qp = QK + (size_t)((r0 + t) * 64 + c0 + l16) * 2048 + h * 64 + quad * 8; qa[t] = *(const bf16x8*)qp; qb[t] = *(const bf16x8*)(qp + 32); }
        f32x4 o[4][4]; float mref[4], lsum[4];
#pragma unroll
        for (int t = 0; t < 4; ++t) { mref[t] = -1e30f; lsum[t] = 0.f;
#pragma unroll
            for (int dt = 0; dt < 4; ++dt) o[t][dt] = (f32x4){0.f, 0.f, 0.f, 0.f}; }
        const int krlo = min(max(r0 - 4, 0), 248), krhi = min(max(r0 + 3 - 4, 0), 248) + 7;
        bf16x8 nA0, nA1, nB0, nB1; u32x2 nva[4], nvb[4];
#define NA_LOADKV(krx) { const int tk_ = (krx) * 64 + cbase; const bf16_t* kp_ = QK + (size_t)(tk_ + l16) * 2048 + 1024 + h * 64 + quad * 8; \
            nA0 = *(const bf16x8*)kp_; nA1 = *(const bf16x8*)(kp_ + 32); nB0 = *(const bf16x8*)(kp_ + 16 * 2048); nB1 = *(const bf16x8*)(kp_ + 16 * 2048 + 32); \
            _Pragma("unroll") for (int dt = 0; dt < 4; ++dt) { const bf16_t* vp_ = Vt + (size_t)(h * 64 + dt * 16 + l16) * T + tk_ + quad * 4; nva[dt] = *(const u32x2*)vp_; nvb[dt] = *(const u32x2*)(vp_ + 16); } }
        NA_LOADKV(krlo)
#pragma unroll 1
        for (int kr = krlo; kr <= krhi; ++kr) {
            const bf16x8 kA0 = nA0, kA1 = nA1, kB0 = nB0, kB1 = nB1;
            bf16x8 vfr[4];
#pragma unroll
            for (int dt = 0; dt < 4; ++dt) { u32x4 vw; vw.x = nva[dt].x; vw.y = nva[dt].y; vw.z = nvb[dt].x; vw.w = nvb[dt].y; vfr[dt] = __builtin_bit_cast(bf16x8, vw); }
            NA_LOADKV(min(kr + 1, krhi))
            SB;
#pragma unroll
            for (int t = 0; t < 4; ++t) { const int srt = min(max(r0 + t - 4, 0), 248); if (kr >= srt && kr <= srt + 7) NA_BLOCK(t, true) }
        }
#define NA_LOADC(kbx) { const bf16_t* kp_ = Kc + ((kbx) * 32 + l16) * 72 + quad * 8; \
            nA0 = *(const bf16x8*)kp_; nA1 = *(const bf16x8*)(kp_ + 32); nB0 = *(const bf16x8*)(kp_ + 16 * 72); nB1 = *(const bf16x8*)(kp_ + 16 * 72 + 32); \
            _Pragma("unroll") for (int dt = 0; dt < 4; ++dt) { const bf16_t* vp_ = Vc + (dt * 16 + l16) * 264 + (kbx) * 32 + quad * 4; nva[dt] = *(const u32x2*)vp_; nvb[dt] = *(const u32x2*)(vp_ + 16); } }
        NA_LOADC(0)
#pragma unroll 1
        for (int kb = 0; kb < 8; ++kb) {
            const int kr = 0; (void)kr;
            const bf16x8 kA0 = nA0, kA1 = nA1, kB0 = nB0, kB1 = nB1;
            bf16x8 vfr[4];
#pragma unroll
            for (int dt = 0; dt < 4; ++dt) { u32x4 vw; vw.x = nva[dt].x; vw.y = nva[dt].y; vw.z = nvb[dt].x; vw.w = nvb[dt].y; vfr[dt] = __builtin_bit_cast(bf16x8, vw); }
            NA_LOADC(min(kb + 1, 7))
            SB;
#pragma unroll
            for (int t = 0; t < 4; ++t) NA_BLOCK(t, false)
        }
#pragma unroll
        for (int t = 0; t < 4; ++t)
#pragma unroll
            for (int j = 0; j < 4; ++j) { const float lt_ = xsum32(xsum16(lsum[t])); const float inv = 1.f / __shfl(lt_, quad * 4 + j);
#pragma unroll
                for (int dt = 0; dt < 4; ++dt) O[(size_t)((r0 + t) * 64 + c0 + quad * 4 + j) * D + h * 64 + dt * 16 + l16] = (bf16_t)f2bf(o[t][dt][j] * inv); }
    }
    __syncthreads();
}
template <class Epi>
__device__ __forceinline__ void run_gemm(unsigned char* lds, const bf16_t* A, const bf16_t* Bt, int M, int N, int K, int G, int c, const Epi& E) {
    pg8::Gemm g{A, Bt, M, N, K, K}; pg8::StaticOrder S; S.init(M, N, G, c);
    pg8::gemm_phase<Epi, pg8::StaticOrder, true, true>((PG8_LAS unsigned char*)lds, g, S, E);
}
template <class Epi>
__device__ __forceinline__ void run_slice(unsigned char* lds, const bf16_t* A, const bf16_t* Bt, int ld, int pn, const Epi& E) {
    pg8::Gemm g{A, Bt, 256, 1024, 256, ld}; OneUnit S{pn};
    pg8::gemm_phase<Epi, OneUnit, true, true>((PG8_LAS unsigned char*)lds, g, S, E);
}
__global__ void __launch_bounds__(512) mega(Args a) {
    extern __shared__ __attribute__((aligned(16))) unsigned char lds[];
    cg::grid_group grid = cg::this_grid();
    { volatile LAS unsigned* st0 = (volatile LAS unsigned*)((LAS unsigned char*)lds + LDS_BAR_OFF); if (threadIdx.x < 4) st0[threadIdx.x] = 0u; }
    __syncthreads();
    XcdBarrier xbar = xcd_barrier_post((unsigned*)(a.ws + OFF_BAR), (volatile LAS unsigned*)((LAS unsigned char*)lds + LDS_BAR_OFF));
    const int lo = a.lo, hi = a.hi, G = gridDim.x, bx = blockIdx.x;
#ifndef PHMASK
#define PHMASK 0x7ffff
#endif
#define IN(k) (((PHMASK >> (k)) & 1) && lo <= (k) && (k) < hi)
#ifndef REPMASK
#define REPMASK 0
#endif
#define REPS(k) for (int rep_ = 0; rep_ < ((((REPMASK) >> (k)) & 1) ? 2 : 1); ++rep_)
#define SEAM(k) do { if (IN(k) && IN((k) + 1)) { if (a.lo < 0) grid.sync(); xcd_barrier(xbar); } } while (0)
    unsigned char* ws = a.ws; const bf16_t* wb = (const bf16_t*)a.out;
    bf16_t* HB = (bf16_t*)(ws + OFF_HBUF); bf16_t* PB = (bf16_t*)(ws + OFF_PBUF); bf16_t* HID = (bf16_t*)(ws + OFF_HID);
    float* Z = (float*)(ws + OFF_Z); float* XA = (float*)(ws + OFF_XA); const float* modr = (const float*)(ws + OFF_MODR);
    const float* lng = a.in[6]; const float* lnb = a.in[7]; float* PART = (float*)((unsigned char*)a.out + WO_PART);
    if (IN(0)) { { phase0(a, lds); } if ((REPMASK >> 0) & 1) { phase0(a, lds); } }
    SEAM(0);
    if (IN(1)) { { phase1(a, lds); } if ((REPMASK >> 1) & 1) { phase1(a, lds); } }
    SEAM(1);
    if (IN(2)) { { run_gemm(lds, HB, wb + WO_WIN0 / 2, T, 3072, 1024, G, bx, EpiStore{PB, PLD}); } if ((REPMASK >> 2) & 1) { run_gemm(lds, HB, wb + WO_WIN0 / 2, T, 3072, 1024, G, bx, EpiStore{PB, PLD}); } }
    SEAM(2);
    if (IN(3)) { { scan_passA(a, lds); ag_rows(a, 240, G - 240, 0, 128); ag_rows(a, 0, 240, 128, T / 16); } if ((REPMASK >> 3) & 1) { scan_passA(a, lds); ag_rows(a, 240, G - 240, 0, 128); ag_rows(a, 0, 240, 128, T / 16); } }
    if (IN(3)) conv_l1_tiles(a, lds, CJ0, CJ4 + 528);
    SEAM(3);
    if (IN(4)) { { if (bx < 192) scan_passB(a, lds); else run_gemm(lds, (const bf16_t*)(ws + OFF_AG), wb + WO_BG / 2, T, 1024, 384, G - 192, bx - 192, EpiStore{HB, D}); } if ((REPMASK >> 4) & 1) { if (bx < 192) scan_passB(a, lds); else run_gemm(lds, (const bf16_t*)(ws + OFF_AG), wb + WO_BG / 2, T, 1024, 384, G - 192, bx - 192, EpiStore{HB, D}); } }
    SEAM(4);
    if (IN(5)) { { scan_passC(a, lds); } if ((REPMASK >> 5) & 1) { scan_passC(a, lds); } }
    if (IN(5)) conv_l1_tiles(a, lds, CJ4 + 528, CJ9);
    SEAM(5);
    if (IN(6)) { { readout_rows(a); } if ((REPMASK >> 6) & 1) { readout_rows(a); } }
    SEAM(6);
    if (IN(7)) { { { run_gemm(lds, HB, wb + WO_WO0 / 2, TL, 1024, 1024, G, bx, EpiRes{a.in[0], a.in[2], modr + 2 * 1024, modr + 6144 + 2 * 1024, Z}); if (bx < 16) { const int sl = bx >> 2; run_slice(lds, HB + (size_t)TL * 1024 + sl * 256, wb + WO_WO0 / 2 + sl * 256, 1024, bx & 3, EpiPart{PART + (size_t)sl * 256 * D}); } } } if ((REPMASK >> 7) & 1) { { run_gemm(lds, HB, wb + WO_WO0 / 2, TL, 1024, 1024, G, bx, EpiRes{a.in[0], a.in[2], modr + 2 * 1024, modr + 6144 + 2 * 1024, Z}); if (bx < 16) { const int sl = bx >> 2; run_slice(lds, HB + (size_t)TL * 1024 + sl * 256, wb + WO_WO0 / 2 + sl * 256, 1024, bx & 3, EpiPart{PART + (size_t)sl * 256 * D}); } } } }
    SEAM(7);
    if (IN(8)) { { ln_pass(Z, T, lng, lnb, XA, HB, modr, 3, 4, PART, 4, a.in[2], modr + 6144 + 2 * 1024); } if ((REPMASK >> 8) & 1) { ln_pass(Z, T, lng, lnb, XA, HB, modr, 3, 4, PART, 4, a.in[2], modr + 6144 + 2 * 1024); } }
    SEAM(8);
    if (IN(9)) { { run_gemm(lds, HB, wb + WO_WUP0 / 2, T, 2 * DFF, 1024, G, bx, EpiSwiglu{HID}); } if ((REPMASK >> 9) & 1) { run_gemm(lds, HB, wb + WO_WUP0 / 2, T, 2 * DFF, 1024, G, bx, EpiSwiglu{HID}); } }
    SEAM(9);
    if (IN(10)) { { { run_gemm(lds, HID, wb + WO_WDN0 / 2, TL, 1024, DFF, G, bx, EpiRes{XA, XA + (size_t)TL * D, modr + 5 * 1024, modr + 6144 + 5 * 1024, Z}); if (bx < 44) { const int sl = bx >> 2; run_slice(lds, HID + (size_t)TL * DFF + sl * 256, wb + WO_WDN0 / 2 + sl * 256, DFF, bx & 3, EpiPart{PART + (size_t)sl * 256 * D}); } } } if ((REPMASK >> 10) & 1) { { run_gemm(lds, HID, wb + WO_WDN0 / 2, TL, 1024, DFF, G, bx, EpiRes{XA, XA + (size_t)TL * D, modr + 5 * 1024, modr + 6144 + 5 * 1024, Z}); if (bx < 44) { const int sl = bx >> 2; run_slice(lds, HID + (size_t)TL * DFF + sl * 256, wb + WO_WDN0 / 2 + sl * 256, DFF, bx & 3, EpiPart{PART + (size_t)sl * 256 * D}); } } } }
    SEAM(10);
    if (IN(11)) { { ln_pass(Z, T, lng + 1024, lnb + 1024, XA, HB, modr + 2 * 6144, 0, 1, PART, 11, XA + (size_t)TL * D, modr + 6144 + 5 * 1024); } if ((REPMASK >> 11) & 1) { ln_pass(Z, T, lng + 1024, lnb + 1024, XA, HB, modr + 2 * 6144, 0, 1, PART, 11, XA + (size_t)TL * D, modr + 6144 + 5 * 1024); } }
    SEAM(11);
    if (IN(12)) { { run_gemm(lds, HB, wb + WO_WIN1 / 2, T, 3072, 1024, G, bx, EpiQKV{(bf16_t*)(ws + OFF_QK), (bf16_t*)(ws + OFF_VT)}); } if ((REPMASK >> 12) & 1) { run_gemm(lds, HB, wb + WO_WIN1 / 2, T, 3072, 1024, G, bx, EpiQKV{(bf16_t*)(ws + OFF_QK), (bf16_t*)(ws + OFF_VT)}); } }
    SEAM(12);
    if (IN(13)) { { natten(a, lds); } if ((REPMASK >> 13) & 1) { natten(a, lds); } }
    SEAM(13);
    if (IN(14)) { { run_gemm(lds, HB, wb + WO_WO1 / 2, TL, 1024, 1024, G, bx, EpiRes{XA, XA + (size_t)TL * D, modr + 2 * 6144 + 2 * 1024, modr + 3 * 6144 + 2 * 1024, Z}); } if ((REPMASK >> 14) & 1) { run_gemm(lds, HB, wb + WO_WO1 / 2, TL, 1024, 1024, G, bx, EpiRes{XA, XA + (size_t)TL * D, modr + 2 * 6144 + 2 * 1024, modr + 3 * 6144 + 2 * 1024, Z}); } }
    SEAM(14);
    if (IN(15)) { { ln_pass(Z, TL, lng + 2048, lnb + 2048, XA, HB, modr + 2 * 6144, 3, 4); } if ((REPMASK >> 15) & 1) { ln_pass(Z, TL, lng + 2048, lnb + 2048, XA, HB, modr + 2 * 6144, 3, 4); } }
    SEAM(15);
    if (IN(16)) { { run_gemm(lds, HB, wb + WO_WUP1 / 2, TL, 2 * DFF, 1024, G, bx, EpiSwiglu{HID}); } if ((REPMASK >> 16) & 1) { run_gemm(lds, HB, wb + WO_WUP1 / 2, TL, 2 * DFF, 1024, G, bx, EpiSwiglu{HID}); } }
    SEAM(16);
    if (IN(17)) { { run_gemm(lds, HID, wb + WO_WDN1 / 2, TL, 1024, DFF, G, bx, EpiRes{XA, XA + (size_t)TL * D, modr + 2 * 6144 + 5 * 1024, modr + 3 * 6144 + 5 * 1024, Z}); } if ((REPMASK >> 17) & 1) { run_gemm(lds, HID, wb + WO_WDN1 / 2, TL, 1024, DFF, G, bx, EpiRes{XA, XA + (size_t)TL * D, modr + 2 * 6144 + 5 * 1024, modr + 3 * 6144 + 5 * 1024, Z}); } }
    SEAM(17);
    if (IN(18)) { { ln_pass(Z, TL, lng + 3072, lnb + 3072, a.out, nullptr, nullptr, 0, 0); } if ((REPMASK >> 18) & 1) { ln_pass(Z, TL, lng + 3072, lnb + 3072, a.out, nullptr, nullptr, 0, 0); } }
}
constexpr int NPHASE = 19;
#ifndef MK_MULTI
#define MK_MULTI 0
#endif
extern "C" void kernel_launch(void* const* d_in, const int* in_sizes, int n_in, void* d_out, int out_size, void* d_ws, size_t ws_size, hipStream_t stream) {
    static int grid = 0;
    if (grid == 0) {
        if (n_in != 29 || out_size != TL * D || ws_size < WS_END) { fprintf(stderr, "kernel_launch: unexpected sizes n_in %d out %d ws %zu (need %zu)\n", n_in, out_size, ws_size, (size_t)WS_END); grid = -1; return; }
        int dev = 0, cus = 0, per_cu = 0;
        hipGetDevice(&dev); hipDeviceGetAttribute(&cus, hipDeviceAttributeMultiprocessorCount, dev);
        if (hipFuncSetAttribute((const void*)mega, hipFuncAttributeMaxDynamicSharedMemorySize, LDS_BYTES) != hipSuccess) { fprintf(stderr, "kernel_launch: hipFuncSetAttribute failed\n"); grid = -1; return; }
        if (hipOccupancyMaxActiveBlocksPerMultiprocessor(&per_cu, (const void*)mega, 512, LDS_BYTES) != hipSuccess || per_cu < 1) { fprintf(stderr, "kernel_launch: occupancy query says %d blocks/CU\n", per_cu); (void)hipGetLastError(); per_cu = 1; }
        grid = cus * (per_cu >= 1 ? 1 : 0);
        if (grid != 256) { fprintf(stderr, "kernel_launch: built for a 256-CU device, got %d\n", grid); if (grid > 256) grid = 256; }
    }
    if (grid < 240) return;
    if (hipMemsetAsync((char*)d_ws + OFF_BAR, 0, XCD_BAR_WORDS * 4, stream) != hipSuccess) { fprintf(stderr, "kernel_launch: memset of barrier words failed\n"); return; }
    Args a{};
    for (int i = 0; i < 29; ++i) a.in[i] = (const float*)d_in[i];
    a.out = (float*)d_out; a.ws = (unsigned char*)d_ws;
#if MK_MULTI
    for (int k = 0; k < NPHASE; ++k) { a.lo = k; a.hi = k + 1; hipLaunchKernelGGL(mega, dim3(grid), dim3(512), LDS_BYTES, stream, a); }
#else
    a.lo = 0; a.hi = NPHASE;
    void* args[] = {&a};
    hipError_t e = hipLaunchCooperativeKernel((const void*)mega, dim3(grid), dim3(512), args, LDS_BYTES, stream);
    if (e != hipSuccess) fprintf(stderr, "kernel_launch: cooperative launch failed: %s (grid %d)\n", hipGetErrorString(e), grid);
#endif
}
```

```cpp
#define DEPC_ 3
#define DEPA_ 2
#define PFA 1
#include <hip/hip_runtime.h>
#include <hip/hip_cooperative_groups.h>
#include <cstdio>
#include <cstdint>
namespace cg = cooperative_groups;
namespace pg8 {
#define PG8_LAS __attribute__((address_space(3)))
typedef unsigned short bf16_t;
typedef short bf16x8 __attribute__((ext_vector_type(8)));
typedef float f32x4 __attribute__((ext_vector_type(4)));
typedef unsigned u32x4 __attribute__((ext_vector_type(4)));
constexpr int BM = 256, BK = 64, HALF = 128, HTB = HALF * BK * 2  , STAGE_BYTES = 8 * HTB, NXCD = 8, WGM = 8;

__host__ __device__ __forceinline__ int lds_byte(int r, int c) { const int st = (r >> 4) * 2 + (c >> 5), rr = r & 15, cc = c & 31, ob = rr * 64 + cc * 2; return st * 1024 + (ob ^ (((ob >> 9) & 1) << 5)); }
__host__ __device__ __forceinline__ void stage_rc(int b, int& R, int& C) { const int st = b / 1024, sb = b % 1024, swz = sb ^ (((sb >> 9) & 1) << 5); R = (st >> 1) * 16 + swz / 64; C = (st & 1) * 32 + (swz % 64) / 2; }
__host__ __device__ __forceinline__ int perm32(int rho) { const int n = rho >> 4, i = rho & 15; return 8 * (i >> 2) + 4 * n + (i & 3); }

struct Unit { int pm, pn; };
struct Gemm { const bf16_t* A; const bf16_t* Bt; int M, N, K, ld; };

struct StaticOrder {
    int nM, nN, nwg, G, c;
    __host__ __device__ void init(int M, int N, int G_, int c_) { nM = M / BM; nN = N / BM; nwg = nM * nN; G = G_; c = c_; }
    __host__ __device__ bool next(int i, Unit& u) const {
        const long L = (long)i * G + c; if (L >= nwg) return false;
        int wgid = (int)L; { const int q = nwg / NXCD, r = nwg % NXCD, xcd = wgid % NXCD, off = wgid / NXCD; wgid = (xcd < r ? xcd * (q + 1) : r * (q + 1) + (xcd - r) * q) + off; }
        const int nig = WGM * nN, gid = wgid / nig, fm = gid * WGM, gsz = (nM - fm) < WGM ? (nM - fm) : WGM;
        u.pm = fm + ((wgid % nig) % gsz); u.pn = (wgid % nig) / gsz; return true;
    }
    __device__ __forceinline__ void a_ready(const Unit&) const {}
    __device__ __forceinline__ void done(const Unit&) const {}
};

__device__ __forceinline__ unsigned cvt_pk_bf16(float lo, float hi) { unsigned r; asm volatile("v_cvt_pk_bf16_f32 %0, %1, %2" : "=v"(r) : "v"(lo), "v"(hi)); return r; }
template <class Epi, class Sched, bool ALIGN_EPI = false, bool SP2 = false>
__device__ __forceinline__ void gemm_phase(PG8_LAS unsigned char* lds, const Gemm g, const Sched& S, const Epi& E) {
    const int tid = threadIdx.x, wid = __builtin_amdgcn_readfirstlane(tid >> 6), lane = tid & 63, wr = wid >> 2, wc = wid & 3, fr = lane & 15, fq = lane >> 4;
    const int K = g.K, nt = K / BK, LD = g.ld;
    unsigned voffA[2], voffB[2];
#pragma unroll
    for (int i = 0; i < 2; ++i) { int R, C; stage_rc(tid * 16 + i * 8192, R, C); const int Rb = Epi::PERM ? ((R & ~31) + perm32(R & 31)) : R;
        voffA[i] = (unsigned)(R * LD + C) * 2u; voffB[i] = (unsigned)(Rb * LD + C) * 2u; }
    const size_t kstep = (size_t)(BK * 2);
    const size_t hstep = (size_t)HALF * LD * 2;
    const size_t tstep = 2 * hstep;
    const unsigned ldsw = (unsigned)wid * 1024u;
    const int aoff = lds_byte(wr * 64 + fr, fq * 8), boff = lds_byte(wc * 32 + fr, fq * 8);
#define PG8_SA(b, h) (((b) * 2 + (h)) * HTB)
#define PG8_SB(b, h) ((4 + (b) * 2 + (h)) * HTB)
#define PG8_STAGE(bufoff, gbase, voff) do { _Pragma("unroll") for (int _i = 0; _i < 2; ++_i) \
        __builtin_amdgcn_global_load_lds((const unsigned*)((const char*)(gbase) + (voff)[_i]), (PG8_LAS unsigned*)(lds + (bufoff) + ldsw + _i * 8192), 16, 0, 0); } while (0)
#define PG8_LDA(dst, b, h) do { _Pragma("unroll") for (int m = 0; m < 4; ++m) _Pragma("unroll") for (int k = 0; k < 2; ++k) dst[m][k] = *(const PG8_LAS bf16x8*)(lds + PG8_SA(b, h) + aoff + m * 2048 + k * 1024); } while (0)
#define PG8_LDB(dst, b, h) do { _Pragma("unroll") for (int n = 0; n < 2; ++n) _Pragma("unroll") for (int k = 0; k < 2; ++k) dst[n][k] = *(const PG8_LAS bf16x8*)(lds + PG8_SB(b, h) + boff + n * 2048 + k * 1024); } while (0)
#define PG8_MMA(ai, bj, At, Bt) do { __builtin_amdgcn_s_setprio(1); _Pragma("unroll") for (int m = 0; m < 4; ++m) _Pragma("unroll") for (int n = 0; n < 2; ++n) _Pragma("unroll") for (int k = 0; k < 2; ++k) \
        acc[ai][bj][m][n] = __builtin_amdgcn_mfma_f32_16x16x32_bf16(Bt[n][k], At[m][k], acc[ai][bj][m][n], 0, 0, 0); __builtin_amdgcn_s_setprio(0); } while (0)
#define PG8_WAIT_V(n) asm volatile("s_waitcnt vmcnt(" #n ")" ::: "memory")
#define PG8_WAIT_L(n) asm volatile("s_waitcnt lgkmcnt(" #n ")" ::: "memory")
#define PG8_BAR __builtin_amdgcn_s_barrier()
#define PG8_SCHED __builtin_amdgcn_sched_barrier(0)
    Unit cur, nxt; int ui = 0;
    if (!S.next(0, cur)) return;
    f32x4 acc[2][2][4][2];
#pragma unroll
    for (int a = 0; a < 2; ++a)
#pragma unroll
        for (int b = 0; b < 2; ++b)
#pragma unroll
            for (int m = 0; m < 4; ++m)
#pragma unroll
                for (int n = 0; n < 2; ++n) acc[a][b][m][n] = (f32x4){0.f, 0.f, 0.f, 0.f};
    bf16x8 At[4][2], B0[2][2], B1[2][2];
    const char* cA = (const char*)g.A + (size_t)cur.pm * tstep; const char* cB = (const char*)g.Bt + (size_t)cur.pn * tstep;
    S.a_ready(cur);
    if constexpr (SP2) {
        PG8_STAGE(PG8_SB(0, 0), cB, voffB); PG8_STAGE(PG8_SB(0, 1), cB + hstep, voffB); PG8_STAGE(PG8_SA(0, 0), cA, voffA); PG8_STAGE(PG8_SA(0, 1), cA + hstep, voffA);
        if (wr == 1) PG8_BAR;
        PG8_WAIT_V(2); PG8_BAR;
        PG8_STAGE(PG8_SB(1, 0), cB + kstep, voffB); PG8_STAGE(PG8_SA(1, 0), cA + kstep, voffA); PG8_STAGE(PG8_SB(1, 1), cB + hstep + kstep, voffB);
        PG8_WAIT_V(6); PG8_BAR;
    } else {
        PG8_STAGE(PG8_SB(0, 0), cB, voffB); PG8_STAGE(PG8_SA(0, 0), cA, voffA); PG8_STAGE(PG8_SB(0, 1), cB + hstep, voffB); PG8_STAGE(PG8_SA(0, 1), cA + hstep, voffA);
        if (wr == 1) PG8_BAR;
        PG8_WAIT_V(4); PG8_BAR;
        PG8_STAGE(PG8_SB(1, 0), cB + kstep, voffB); PG8_STAGE(PG8_SA(1, 0), cA + kstep, voffA); PG8_STAGE(PG8_SB(1, 1), cB + hstep + kstep, voffB);
        PG8_WAIT_V(6); PG8_BAR;
    }
    for (;;) {
        const bool has_next = S.next(ui + 1, nxt);
        const char* nA = has_next ? (const char*)g.A + (size_t)nxt.pm * tstep : cA; const char* nB = has_next ? (const char*)g.Bt + (size_t)nxt.pn * tstep : cB;
        for (int t = 0; t < nt; t += 2) {
            const bool last = (t == nt - 2);
            const char* a1 = cA + (size_t)(t + 1) * kstep;
            const char* a2 = last ? nA : cA + (size_t)(t + 2) * kstep; const char* b2 = last ? nB : cB + (size_t)(t + 2) * kstep;
            const char* a3 = a2 + kstep; const char* b3 = b2 + kstep;
            if (last && has_next) S.a_ready(nxt);
            if constexpr (SP2) {
            PG8_LDB(B0, 0, 0); PG8_LDB(B1, 0, 1); PG8_SCHED; PG8_LDA(At, 0, 0); PG8_STAGE(PG8_SA(1, 1), a1 + hstep, voffA);
            PG8_WAIT_V(8); PG8_WAIT_L(0); PG8_BAR; PG8_MMA(0, 0, At, B0); PG8_MMA(0, 1, At, B1); PG8_BAR; PG8_SCHED;
            PG8_LDA(At, 0, 1); PG8_STAGE(PG8_SB(0, 0), b2, voffB); PG8_STAGE(PG8_SB(0, 1), b2 + hstep, voffB); PG8_STAGE(PG8_SA(0, 0), a2, voffA);
            PG8_WAIT_V(8); PG8_WAIT_L(0); PG8_BAR; PG8_MMA(1, 0, At, B0); PG8_MMA(1, 1, At, B1); PG8_BAR; PG8_SCHED;
            PG8_LDB(B0, 1, 0); PG8_LDB(B1, 1, 1); PG8_SCHED; PG8_LDA(At, 1, 0); PG8_STAGE(PG8_SA(0, 1), a2 + hstep, voffA);
            PG8_WAIT_V(8); PG8_WAIT_L(0); PG8_BAR; PG8_MMA(0, 0, At, B0); PG8_MMA(0, 1, At, B1); PG8_BAR; PG8_SCHED;
            PG8_LDA(At, 1, 1); PG8_STAGE(PG8_SB(1, 0), b3, voffB); PG8_STAGE(PG8_SB(1, 1), b3 + hstep, voffB); PG8_STAGE(PG8_SA(1, 0), a3, voffA);
            PG8_WAIT_V(8); PG8_WAIT_L(0); PG8_BAR; PG8_MMA(1, 0, At, B0); PG8_MMA(1, 1, At, B1); PG8_BAR; PG8_SCHED;
            } else {
            PG8_LDB(B0, 0, 0); PG8_SCHED; PG8_LDA(At, 0, 0); PG8_STAGE(PG8_SA(1, 1), a1 + hstep, voffA);
            PG8_WAIT_L(8); PG8_BAR; PG8_WAIT_L(0); PG8_MMA(0, 0, At, B0); PG8_BAR; PG8_SCHED;
            PG8_LDB(B1, 0, 1); PG8_STAGE(PG8_SB(0, 0), b2, voffB);
            PG8_BAR; PG8_WAIT_L(0); PG8_MMA(0, 1, At, B1); PG8_BAR;
            PG8_LDA(At, 0, 1); PG8_STAGE(PG8_SA(0, 0), a2, voffA);
            PG8_BAR; PG8_WAIT_L(0); PG8_MMA(1, 0, At, B0); PG8_BAR; PG8_SCHED;
            PG8_STAGE(PG8_SB(0, 1), b2 + hstep, voffB);
            PG8_WAIT_V(6); PG8_BAR; PG8_MMA(1, 1, At, B1); PG8_BAR;
            PG8_LDB(B0, 1, 0); PG8_SCHED; PG8_LDA(At, 1, 0); PG8_STAGE(PG8_SA(0, 1), a2 + hstep, voffA);
            PG8_WAIT_L(8); PG8_BAR; PG8_WAIT_L(0); PG8_MMA(0, 0, At, B0); PG8_BAR; PG8_SCHED;
            PG8_LDB(B1, 1, 1); PG8_STAGE(PG8_SB(1, 0), b3, voffB);
            PG8_BAR; PG8_WAIT_L(0); PG8_MMA(0, 1, At, B1); PG8_BAR;
            PG8_LDA(At, 1, 1); PG8_STAGE(PG8_SA(1, 0), a3, voffA);
            PG8_BAR; PG8_WAIT_L(0); PG8_MMA(1, 0, At, B0); PG8_BAR; PG8_SCHED;
            PG8_STAGE(PG8_SB(1, 1), b3 + hstep, voffB);
            PG8_WAIT_V(6); PG8_BAR; PG8_MMA(1, 1, At, B1); PG8_BAR;
            }
        }
        if constexpr (ALIGN_EPI) { if (wr == 0) PG8_BAR; }
        if constexpr (!Epi::AFTER_DRAIN) { E(acc, cur, wr, wc, fr, fq); S.done(cur); }
        if (!has_next) break;
#pragma unroll
        for (int a = 0; a < 2; ++a)
#pragma unroll
            for (int b = 0; b < 2; ++b)
#pragma unroll
                for (int m = 0; m < 4; ++m)
#pragma unroll
                    for (int n = 0; n < 2; ++n) acc[a][b][m][n] = (f32x4){0.f, 0.f, 0.f, 0.f};
        cur = nxt; cA = nA; cB = nB; ++ui;
        if constexpr (ALIGN_EPI) { if (wr == 1) PG8_BAR; }
    }
    PG8_WAIT_V(0);
    if constexpr (!ALIGN_EPI) { if (wr == 0) PG8_BAR; }
    PG8_BAR;
    if constexpr (Epi::AFTER_DRAIN) { E.fused(acc, cur, wr, wc, fr, fq, lds, wid, lane); S.done(cur); }
#undef PG8_SA
#undef PG8_SB
#undef PG8_STAGE
#undef PG8_LDA
#undef PG8_LDB
#undef PG8_MMA
#undef PG8_WAIT_V
#undef PG8_WAIT_L
#undef PG8_BAR
#undef PG8_SCHED
}
}
using pg8::bf16_t; using pg8::bf16x8; using pg8::f32x4; using pg8::Unit;
typedef float f32x2 __attribute__((ext_vector_type(2)));
typedef unsigned u32x4 __attribute__((ext_vector_type(4)));
typedef unsigned u32x2 __attribute__((ext_vector_type(2)));

constexpr int TL = 16384, TC = 256, T = TL + TC, D = 1024, DFF = 2816, DA = 768;
constexpr int PLD = 3072;
constexpr int NC = 80, CH = 208, NS = 8;
constexpr float ALPHA = 1.41421356237f, LN_EPS = 1e-6f, GN_EPS = 64e-5f;
constexpr int KS = 8;
constexpr size_t OFF_PBUF = 0, OFF_Z = 0, OFF_QK = 0;
constexpr size_t OFF_HID = 68157440ull, OFF_VT = 68157440ull;
constexpr size_t OFF_PQ = 102236160ull, OFF_Y = 165150720ull, OFF_AG = 216268800ull;
constexpr size_t OFF_XA = 161873920ull, OFF_HBUF = 230031360ull;
constexpr size_t OFF_MODP = 264110080ull, OFF_MODR = OFF_MODP + 786432ull, OFF_COEF = OFF_MODR + 98304ull, OFF_BAR = OFF_COEF + 1597440ull, WS_END = OFF_BAR + 16384ull;
constexpr size_t WO_WIN0 = 0, WO_WO0 = 6291456, WO_WUP0 = 8388608, WO_WDN0 = 19922944, WO_WIN1 = 25690112, WO_WO1 = 31981568, WO_WUP1 = 34078720, WO_WDN1 = 45613056,
                 WO_W2T = 51380224, WO_A2T = 51576832, WO_BG = 51773440, WO_PART = 52559872;
constexpr int WAVE_LDS = 16896, LDS_BAR_OFF = 8 * WAVE_LDS + 22272, LDS_BYTES = LDS_BAR_OFF + 16;

struct Args { const float* in[29]; float* out; unsigned char* ws; int lo, hi; };

__device__ __forceinline__ unsigned f2bf(float f) { unsigned u = __builtin_bit_cast(unsigned, f); return (u + 0x7fffu + ((u >> 16) & 1u)) >> 16; }
__device__ __forceinline__ float bf2f(unsigned short b) { return __builtin_bit_cast(float, ((unsigned)b) << 16); }
__device__ __forceinline__ unsigned pk2(float lo, float hi) { return f2bf(lo) | (f2bf(hi) << 16); }
template <int CTRL> __device__ __forceinline__ float dppf(float x) { return __builtin_bit_cast(float, __builtin_amdgcn_update_dpp(0, __builtin_bit_cast(int, x), CTRL, 0xf, 0xf, true)); }
__device__ __forceinline__ float sum16(float v) { v += dppf<0xB1>(v); v += dppf<0x4E>(v); v += dppf<0x124>(v); v += dppf<0x128>(v); return v; }
__device__ __forceinline__ float xsum16(float v) { return v + __shfl_xor(v, 16); }
__device__ __forceinline__ float xsum32(float v) { return v + __shfl_xor(v, 32); }
__device__ __forceinline__ float xmax16(float v) { return fmaxf(v, __shfl_xor(v, 16)); }
__device__ __forceinline__ float xmax32(float v) { return fmaxf(v, __shfl_xor(v, 32)); }
__device__ __forceinline__ float wsum(float v) { return xsum32(xsum16(sum16(v))); }
__device__ __forceinline__ float rcp_(float x) { return __builtin_amdgcn_rcpf(x); }
__device__ __forceinline__ float sigm(float x) { return rcp_(1.f + __expf(-x)); }
__device__ __forceinline__ void wave_sync() { __builtin_amdgcn_fence(__ATOMIC_SEQ_CST, "wavefront"); __builtin_amdgcn_wave_barrier(); }

struct EpiStore {
    static constexpr bool PERM = true, AFTER_DRAIN = false;
    bf16_t* O; int ldc;
    __device__ __forceinline__ void operator()(const f32x4 (&acc)[2][2][4][2], const Unit& u, int wr, int wc, int fr, int fq) const {
        const int row0 = u.pm * 256 + wr * 64 + fr, col0 = u.pn * 256 + wc * 32 + 8 * fq;
#pragma unroll
        for (int ai = 0; ai < 2; ++ai)
#pragma unroll
            for (int m = 0; m < 4; ++m) { bf16_t* rp = O + (size_t)(row0 + ai * 128 + m * 16) * ldc + col0;
#pragma unroll
                for (int bj = 0; bj < 2; ++bj) { const f32x4 a = acc[ai][bj][m][0], b = acc[ai][bj][m][1]; u32x4 w; w.x = pk2(a[0], a[1]); w.y = pk2(a[2], a[3]); w.z = pk2(b[0], b[1]); w.w = pk2(b[2], b[3]); *(u32x4*)(rp + bj * 128) = w; } }
    }
};
struct EpiQKV {
    static constexpr bool PERM = true, AFTER_DRAIN = false;
    bf16_t* QK; bf16_t* Vt;
    __device__ __forceinline__ void operator()(const f32x4 (&acc)[2][2][4][2], const Unit& u, int wr, int wc, int fr, int fq) const {
        const int row0 = u.pm * 256 + wr * 64 + fr, col0 = u.pn * 256 + wc * 32 + 8 * fq;
        if (u.pn < 8) {
#pragma unroll
            for (int ai = 0; ai < 2; ++ai)
#pragma unroll
                for (int m = 0; m < 4; ++m) { bf16_t* rp = QK + (size_t)(row0 + ai * 128 + m * 16) * 2048 + col0;
#pragma unroll
                    for (int bj = 0; bj < 2; ++bj) { const f32x4 a = acc[ai][bj][m][0], b = acc[ai][bj][m][1]; u32x4 w; w.x = pk2(a[0], a[1]); w.y = pk2(a[2], a[3]); w.z = pk2(b[0], b[1]); w.w = pk2(b[2], b[3]); *(u32x4*)(rp + bj * 128) = w; } }
        } else {
            bf16_t* vb = Vt + (size_t)(col0 - 2048) * T + row0;
#pragma unroll 1
            for (int bj = 0; bj < 2; ++bj)
#pragma unroll
                for (int n = 0; n < 2; ++n)
#pragma unroll
                    for (int e = 0; e < 4; ++e) { bf16_t* cp = vb + (size_t)(bj * 128 + 4 * n + e) * T;
#pragma unroll
                        for (int ai = 0; ai < 2; ++ai)
#pragma unroll
                            for (int m = 0; m < 4; ++m) cp[ai * 128 + m * 16] = (bf16_t)f2bf(bj ? acc[ai][1][m][n][e] : acc[ai][0][m][n][e]); }
        }
    }
};
struct EpiSwiglu {
    static constexpr bool PERM = true, AFTER_DRAIN = false;
    bf16_t* O;
    __device__ __forceinline__ void operator()(const f32x4 (&acc)[2][2][4][2], const Unit& u, int wr, int wc, int fr, int fq) const {
        const int row0 = u.pm * 256 + wr * 64 + fr, col0 = u.pn * 128 + wc * 32 + 8 * fq;
#pragma unroll
        for (int ai = 0; ai < 2; ++ai)
#pragma unroll
            for (int m = 0; m < 4; ++m) { float h[8];
#pragma unroll
                for (int n = 0; n < 2; ++n)
#pragma unroll
                    for (int e = 0; e < 4; ++e) { const float a = acc[ai][0][m][n][e], b = acc[ai][1][m][n][e]; h[n * 4 + e] = a * sigm(a) * b; }
                u32x4 w; w.x = pk2(h[0], h[1]); w.y = pk2(h[2], h[3]); w.z = pk2(h[4], h[5]); w.w = pk2(h[6], h[7]);
                *(u32x4*)(O + (size_t)(row0 + ai * 128 + m * 16) * DFF + col0) = w; }
    }
};
struct EpiRes {
    static constexpr bool PERM = true, AFTER_DRAIN = false;
    const float* xlat; const float* xctx; const float* glat; const float* gctx; float* Z;
    __device__ __forceinline__ void operator()(const f32x4 (&acc)[2][2][4][2], const Unit& u, int wr, int wc, int fr, int fq) const {
        const int row0 = u.pm * 256 + wr * 64 + fr, col0 = u.pn * 256 + wc * 32 + 8 * fq;
        const bool isctx = (u.pm * 256 >= TL);
        const float* gate = isctx ? gctx : glat;
        f32x4 gv[2][2];
#pragma unroll
        for (int bj = 0; bj < 2; ++bj)
#pragma unroll
            for (int n = 0; n < 2; ++n) gv[bj][n] = *(const f32x4*)(gate + col0 + bj * 128 + 4 * n);
#pragma unroll
        for (int ai = 0; ai < 2; ++ai)
#pragma unroll
            for (int m = 0; m < 4; ++m) { const int row = row0 + ai * 128 + m * 16;
                const float* xr = isctx ? xctx + (size_t)(row - TL) * D : xlat + (size_t)row * D; float* zr = Z + (size_t)row * D;
#pragma unroll
                for (int bj = 0; bj < 2; ++bj)
#pragma unroll
                    for (int n = 0; n < 2; ++n) { const int c = col0 + bj * 128 + 4 * n; const f32x4 xv = *(const f32x4*)(xr + c); *(f32x4*)(zr + c) = xv * ALPHA + gv[bj][n] * acc[ai][bj][m][n]; } }
    }
};

struct EpiPart {
    static constexpr bool PERM = true, AFTER_DRAIN = false;
    float* P;
    __device__ __forceinline__ void operator()(const f32x4 (&acc)[2][2][4][2], const Unit& u, int wr, int wc, int fr, int fq) const {
        const int row0 = wr * 64 + fr, col0 = u.pn * 256 + wc * 32 + 8 * fq;
#pragma unroll
        for (int ai = 0; ai < 2; ++ai)
#pragma unroll
            for (int m = 0; m < 4; ++m) { float* zr = P + (size_t)(row0 + ai * 128 + m * 16) * D;
#pragma unroll
                for (int bj = 0; bj < 2; ++bj)
#pragma unroll
                    for (int n = 0; n < 2; ++n) *(f32x4*)(zr + col0 + bj * 128 + 4 * n) = acc[ai][bj][m][n]; }
    }
};
struct OneUnit { int pn;
    __device__ __forceinline__ bool next(int i, Unit& u) const { if (i != 0) return false; u.pm = 0; u.pn = pn; return true; }
    __device__ __forceinline__ void a_ready(const Unit&) const {}
    __device__ __forceinline__ void done(const Unit&) const {}
};
#define LAS __attribute__((address_space(3)))
#define XB_TMO      128
#define XB_XCNT(j)  (256  + 64 * (j))
#define XB_XSUB(j)  (1280 + 64 * (j))
#define XB_XGEN(j)  (2304 + 64 * (j))
#define XB_TOP      3328
#define XB_TOPGEN   3392
#define XCD_BAR_WORDS 3456
#define XB_SPIN_CAP (1u << 18)

__device__ __forceinline__ unsigned xb_ld(unsigned* p)              { return __hip_atomic_load(p, __ATOMIC_RELAXED, __HIP_MEMORY_SCOPE_AGENT); }
__device__ __forceinline__ unsigned xb_add(unsigned* p, unsigned v) { return __hip_atomic_fetch_add(p, v, __ATOMIC_RELAXED, __HIP_MEMORY_SCOPE_AGENT); }
__device__ __forceinline__ unsigned xb_xcc_id() { return (unsigned)__builtin_amdgcn_s_getreg((3 << 11) | 20) & 0xFu; }
#define XB_SPIN(cond, bar) do { unsigned _sp = 0; while (cond) { __builtin_amdgcn_s_sleep(1); \
    if ((++_sp & 255u) == 0u) { if (xb_ld(&(bar)[XB_TMO])) break; if (_sp > XB_SPIN_CAP) { atomicAdd(&(bar)[XB_TMO], 1u); break; } } } } while (0)

struct XcdBarrier {
    unsigned* bar; unsigned x;
    volatile LAS unsigned* st;
};

__device__ __forceinline__ XcdBarrier xcd_barrier_post(unsigned* bar, volatile LAS unsigned* st) {
    XcdBarrier b; b.bar = bar; b.x = xb_xcc_id(); b.st = st;
    if (threadIdx.x == 0) (void)xb_add(&bar[XB_XCNT(b.x)], 1u);
    return b;
}
__device__ __forceinline__ void xcd_barrier_complete(unsigned* bar, unsigned x, unsigned& nloc, unsigned& nx) {
    const unsigned G = gridDim.x * gridDim.y * gridDim.z;
    unsigned sum, cnt, mine, sp = 0u;
    for (;;) {
        sum = 0u; cnt = 0u; mine = 0u;
#pragma unroll
        for (unsigned j = 0; j < 16; ++j) { const unsigned c = xb_ld(&bar[XB_XCNT(j)]); sum += c; cnt += (c > 0u) ? 1u : 0u; mine = (j == x) ? c : mine; }
        if (sum == G) break;
        __builtin_amdgcn_s_sleep(1);
        if ((++sp & 255u) == 0u) { if (xb_ld(&bar[XB_TMO])) break; if (sp > XB_SPIN_CAP) { atomicAdd(&bar[XB_TMO], 1u); break; } }
    }
    nloc = mine > 0u ? mine : 1u; nx = cnt > 0u ? cnt : 1u;
}

__device__ __forceinline__ void xcd_barrier(const XcdBarrier& b) {
    asm volatile("s_waitcnt vmcnt(0)" ::: "memory");
    __syncthreads();
    if (threadIdx.x == 0) {
        unsigned* bar = b.bar;
        __builtin_amdgcn_s_waitcnt(0);
        unsigned nloc = b.st[0], nx = b.st[1];
        if (nloc == 0u) { xcd_barrier_complete(bar, b.x, nloc, nx); b.st[0] = nloc; b.st[1] = nx; }
        const unsigned old = xb_add(&bar[XB_XSUB(b.x)], 1u);
        const unsigned gen = old / nloc;
        if (old + 1u == (gen + 1u) * nloc) {
            __builtin_amdgcn_fence(__ATOMIC_RELEASE, "agent");
            asm volatile("s_waitcnt vmcnt(0)" ::: "memory");
            const unsigned og = xb_add(&bar[XB_TOP], 1u);
            const unsigned tg = og / nx;
            if (og + 1u == (tg + 1u) * nx) xb_add(&bar[XB_TOPGEN], 1u);
            else XB_SPIN(xb_ld(&bar[XB_TOPGEN]) == tg, bar);
            __builtin_amdgcn_fence(__ATOMIC_ACQUIRE, "agent");
            xb_add(&bar[XB_XGEN(b.x)], 1u);
            asm volatile("s_waitcnt vmcnt(0)" ::: "memory");
        } else {
            XB_SPIN(xb_ld(&bar[XB_XGEN(b.x)]) == gen, bar);
            __builtin_amdgcn_fence(__ATOMIC_ACQUIRE, "agent");
            asm volatile("s_waitcnt vmcnt(0)" ::: "memory");
        }
    }
    __syncthreads();
}

__device__ __forceinline__ void tconv_tile(const float* __restrict__ W, int K, int N, bf16_t* __restrict__ dst, int ld, int mode, int tile, float* tl) {
    const int tid = threadIdx.x, tx = tid & 63, ty = tid >> 6;
    const int nkt = K >> 6, kt = tile % nkt, nt = tile / nkt, k0 = kt * 64, n0 = nt * 64;
#pragma unroll
    for (int rr = 0; rr < 8; ++rr) { const int kk = ty * 8 + rr; tl[kk * 65 + tx] = W[(size_t)(k0 + kk) * N + n0 + tx]; }
    __syncthreads();
#pragma unroll
    for (int rr = 0; rr < 8; ++rr) { const int nn = ty * 8 + rr, n = n0 + nn; const int row = (mode == 0) ? n : ((n >> 7) * 256 + (n & 127) + (mode == 2 ? 128 : 0));
        dst[(size_t)row * ld + k0 + tx] = (bf16_t)f2bf(tl[tx * 65 + nn]); }
    __syncthreads();
}
constexpr int CJ0 = 736, CJ1 = CJ0 + 256, CJ2 = CJ1 + 704, CJ3 = CJ2 + 704, CJ4 = CJ3 + 704, CJ5 = CJ4 + 768, CJ6 = CJ5 + 256, CJ7 = CJ6 + 704, CJ8 = CJ7 + 704, CJ9 = CJ8 + 704;
__device__ __forceinline__ void conv_tile_job(const Args& a, int t, float* tl) {
    bf16_t* wb = (bf16_t*)a.out;
    if (t < CJ0) tconv_tile(a.in[11], 1024, 2944, wb + WO_WIN0 / 2, 1024, 0, t, tl);
    else if (t < CJ1) tconv_tile(a.in[25], 1024, 1024, wb + WO_WO0 / 2, 1024, 0, t - CJ0, tl);
    else if (t < CJ2) tconv_tile(a.in[8], 1024, DFF, wb + WO_WUP0 / 2, 1024, 1, t - CJ1, tl);
    else if (t < CJ3) tconv_tile(a.in[9], 1024, DFF, wb + WO_WUP0 / 2, 1024, 2, t - CJ2, tl);
    else if (t < CJ4) tconv_tile(a.in[10], DFF, 1024, wb + WO_WDN0 / 2, DFF, 0, t - CJ3, tl);
    else if (t < CJ5) tconv_tile(a.in[26], 1024, 3072, wb + WO_WIN1 / 2, 1024, 0, t - CJ4, tl);
    else if (t < CJ6) tconv_tile(a.in[28], 1024, 1024, wb + WO_WO1 / 2, 1024, 0, t - CJ5, tl);
    else if (t < CJ7) tconv_tile(a.in[8] + (size_t)D * DFF, 1024, DFF, wb + WO_WUP1 / 2, 1024, 1, t - CJ6, tl);
    else if (t < CJ8) tconv_tile(a.in[9] + (size_t)D * DFF, 1024, DFF, wb + WO_WUP1 / 2, 1024, 2, t - CJ7, tl);
    else tconv_tile(a.in[10] + (size_t)D * DFF, DFF, 1024, wb + WO_WDN1 / 2, DFF, 0, t - CJ8, tl);
}
__device__ __forceinline__ void conv_l1_tiles(const Args& a, unsigned char* lds, int t_lo, int t_hi) {
    if ((int)blockIdx.x < 240) return;
    for (int t = t_lo + ((int)blockIdx.x - 240); t < t_hi; t += (int)gridDim.x - 240) conv_tile_job(a, t, (float*)lds);
}
__device__ __forceinline__ void phase0(const Args& a, unsigned char* lds) {
    float* tl = (float*)lds; const int tid = threadIdx.x;
    bf16_t* wb = (bf16_t*)a.out;
    float* modp = (float*)(a.ws + OFF_MODP);
    constexpr int NG = 2 * 12 * KS;
    for (int it = blockIdx.x; it < NG + CJ0; it += gridDim.x) {
        if (it < NG) {
            const int layer = it / (12 * KS), cb = (it % (12 * KS)) / KS, ks = it % KS, col = cb * 512 + tid;
            if (tid < 256) { const float v = (tid < 128) ? a.in[1][ks * 128 + tid] : a.in[3][ks * 128 + tid - 128]; tl[tid] = v * sigm(v); }
            __syncthreads();
            const float* W = a.in[4] + (size_t)layer * D * 6144 + (size_t)(ks * 128) * 6144 + col;
            float a0 = 0.f, a1 = 0.f;
#pragma unroll 8
            for (int k = 0; k < 128; ++k) { const float w = W[(size_t)k * 6144]; a0 += tl[k] * w; a1 += tl[128 + k] * w; }
            if (ks == 0) { const float b = a.in[5][layer * 6144 + col]; a0 += b; a1 += b; }
            modp[((layer * 2 + 0) * KS + ks) * 6144 + col] = a0; modp[((layer * 2 + 1) * KS + ks) * 6144 + col] = a1;
            __syncthreads();
        } else conv_tile_job(a, it - NG, tl);
    }
    constexpr int E0 = 128 * 1024, E1 = E0 + 98304, E2 = E1 + 98304, E3 = E2 + 393216;
    for (int e = blockIdx.x * 512 + tid; e < E3; e += gridDim.x * 512) {
        if (e < E0) wb[WO_WIN0 / 2 + (size_t)2944 * 1024 + e] = 0;
        else if (e < E1) { const int i = e - E0, d = i / 49152, r = (i % 49152) / 64, k = i % 64; wb[WO_W2T / 2 + i] = (bf16_t)f2bf(a.in[14][(d * 64 + k) * DA + r]); }
        else if (e < E2) { const int i = e - E1, d = i / 49152, r = (i % 49152) / 64, k = i % 64; wb[WO_A2T / 2 + i] = (bf16_t)f2bf(a.in[16][(d * 64 + k) * DA + r]); }
        else { const int i = e - E2, row = i / 384, col = i % 384; float v = 0.f;
            if (row < 768) { if (col < 128) v = a.in[17][col * DA + row]; }
            else { const int g = (row - 768) >> 6, dd = (row - 768) & 63, cc = col - 128 - g * 64; if (cc >= 0 && cc < 64) v = a.in[23][(g * 64 + cc) * 64 + dd] * a.in[24][row - 768]; }
            wb[WO_BG / 2 + i] = (bf16_t)f2bf(v); }
    }
}
__device__ __forceinline__ void phase1(const Args& a, unsigned char* lds) {
    const int tid = threadIdx.x, lane = tid & 63, wave = tid >> 6;
    const float* modp = (const float*)(a.ws + OFF_MODP); float* modr = (float*)(a.ws + OFF_MODR);
    const int gid = blockIdx.x * 512 + tid;
    if (gid < 4 * 6144) { const int lv = gid / 6144, col = gid % 6144; float s = 0.f;
#pragma unroll
        for (int k = 0; k < KS; ++k) s += modp[(lv * KS + k) * 6144 + col];
        modr[gid] = s; }
    float* ml = (float*)lds;
    for (int i = tid; i < 4096; i += 512) { const int which = i >> 10, col = i & 1023, vec = which >> 1, chunk = which & 1; float s = 0.f;
#pragma unroll
        for (int k = 0; k < KS; ++k) s += modp[((0 * 2 + vec) * KS + k) * 6144 + chunk * 1024 + col];
        ml[i] = s; }
    __syncthreads();
    bf16_t* H = (bf16_t*)(a.ws + OFF_HBUF);
#pragma unroll 2
    for (int row = blockIdx.x * 8 + wave; row < T; row += gridDim.x * 8) {
        const float* src = row < TL ? a.in[0] + (size_t)row * D : a.in[2] + (size_t)(row - TL) * D; const float* mm = ml + (row < TL ? 0 : 2048);
#pragma unroll
        for (int q = 0; q < 4; ++q) { const int col = q * 256 + lane * 4; const f32x4 v = *(const f32x4*)(src + col), sh = *(const f32x4*)(mm + col), sc = *(const f32x4*)(mm + 1024 + col);
            const f32x4 h = v * (sc + 1.0f) + sh; u32x2 w; w.x = pk2(h[0], h[1]); w.y = pk2(h[2], h[3]); *(u32x2*)(H + (size_t)row * D + col) = w; }
    }
    __syncthreads();
}
__device__ __forceinline__ void ln_pass(const float* __restrict__ Z, int rows, const float* __restrict__ g, const float* __restrict__ b, float* XO,
                                        bf16_t* __restrict__ H, const float* __restrict__ modr_layer  , int sh_idx, int sc_idx,
                                        const float* part = nullptr, int nsl = 0, const float* xres_ctx = nullptr, const float* gate_ctx = nullptr) {
    const int lane = threadIdx.x & 63, wave = threadIdx.x >> 6;
#pragma unroll 2
    for (int row = blockIdx.x * 8 + wave; row < rows; row += gridDim.x * 8) {
        f32x4 v[4]; float s = 0.f;
#pragma unroll
        for (int q = 0; q < 4; ++q) { const int col = q * 256 + lane * 4;
            if (part && row >= TL) {
                f32x4 sacc = (f32x4){0.f, 0.f, 0.f, 0.f};
                for (int sl = 0; sl < nsl; ++sl) sacc += *(const f32x4*)(part + ((size_t)sl * 256 + (row - TL)) * D + col);
                v[q] = *(const f32x4*)(xres_ctx + (size_t)(row - TL) * D + col) * ALPHA + *(const f32x4*)(gate_ctx + col) * sacc;
            } else v[q] = *(const f32x4*)(Z + (size_t)row * D + col);
            s += (v[q][0] + v[q][1]) + (v[q][2] + v[q][3]); }
        const float mu = wsum(s) * (1.f / 1024.f); float qq = 0.f;
#pragma unroll
        for (int q = 0; q < 4; ++q) { const f32x4 dl = v[q] - mu; qq += (dl[0] * dl[0] + dl[1] * dl[1]) + (dl[2] * dl[2] + dl[3] * dl[3]); }
        const float rstd = rsqrtf(wsum(qq) * (1.f / 1024.f) + LN_EPS);
        const float* mv = H ? modr_layer + (row < TL ? 0 : 6144) : nullptr;
#pragma unroll
        for (int q = 0; q < 4; ++q) { const int col = q * 256 + lane * 4; const f32x4 gg = *(const f32x4*)(g + col), bb = *(const f32x4*)(b + col);
            const f32x4 xn = (v[q] - mu) * rstd * gg + bb; *(f32x4*)(XO + (size_t)row * D + col) = xn;
            if (H) { const f32x4 sh = *(const f32x4*)(mv + sh_idx * 1024 + col), sc = *(const f32x4*)(mv + sc_idx * 1024 + col); const f32x4 h = xn * (sc + 1.0f) + sh;
                u32x2 w; w.x = pk2(h[0], h[1]); w.y = pk2(h[2], h[3]); *(u32x2*)(H + (size_t)row * D + col) = w; } }
    }
}
__device__ __forceinline__ void ag_rows(const Args& a, int b0, int nb, int s_lo, int s_hi) {
    if ((int)blockIdx.x < b0 || (int)blockIdx.x >= b0 + nb) return;
    const int lane = threadIdx.x & 63, wave = threadIdx.x >> 6;
    const bf16_t* P = (const bf16_t*)(a.ws + OFF_PBUF); bf16_t* AG = (bf16_t*)(a.ws + OFF_AG);
    const float* mu = a.in[12];
    const int gc = 2560 + lane * 2; const float m00 = mu[gc], m01 = mu[gc + 1], m10 = mu[2688 + gc], m11 = mu[2688 + gc + 1];
    const int hsel = lane >> 4;
    for (int st = s_lo + ((int)blockIdx.x - b0) * 8 + wave; st < s_hi; st += nb * 8) {
        const int m0 = st * 16, s0 = m0 < TL ? 0 : TL, len = m0 < TL ? TL : TC, t0 = m0 - s0;
        const int cc = 2688 + lane * 4;
        u32x2 x[32]; unsigned gx[18];
#pragma unroll
        for (int j = 0; j < 32; ++j) { const int t = t0 - 8 + j; x[j] = (t >= 0 && t < len) ? *(const u32x2*)(P + (size_t)(s0 + t) * PLD + cc) : (u32x2){0u, 0u}; }
#pragma unroll
        for (int j = 0; j < 18; ++j) { const int t = t0 - 1 + j; gx[j] = (t >= 0 && t < len) ? *(const unsigned*)(P + (size_t)(s0 + t) * PLD + gc) : 0u; }
#pragma unroll
        for (int r = 0; r < 16; ++r) {
            const int t = t0 + r, m = m0 + r;
            { const unsigned cu = gx[r + 1], pu = gx[r], nu = gx[r + 2];
              const float c0 = bf2f(cu & 0xffff), c1 = bf2f(cu >> 16), p0 = bf2f(pu & 0xffff), p1 = bf2f(pu >> 16), n0 = bf2f(nu & 0xffff), n1 = bf2f(nu >> 16);
              const float x0 = c0 + (p0 - c0) * m00 + (n0 - c0) * m10, x1 = c1 + (p1 - c1) * m01 + (n1 - c1) * m11;
              *(unsigned*)(AG + (size_t)m * 384 + lane * 2) = pk2(sigm(x0), sigm(x1)); }
            f32x4 sw = (f32x4){0.f, 0.f, 0.f, 0.f}, acc = (f32x4){0.f, 0.f, 0.f, 0.f};
#pragma unroll
            for (int lv = 0; lv < 4; ++lv) { const int hw = 1 << lv, hp = hw >> 1;
#pragma unroll
                for (int j = -hw; j < hw; ++j) if (lv == 0 || j < -hp || j >= hp) { const u32x2 w = x[r + 8 + j]; acc += (f32x4){bf2f(w.x & 0xffff), bf2f(w.x >> 16), bf2f(w.y & 0xffff), bf2f(w.y >> 16)}; }
                if (hsel == lv) sw = acc; }
            const int half = 1 << hsel; const int lo = max(t - half, 0), hi = min(t + half, len); const float inv = rcp_((float)(hi - lo));
            const u32x2 cw = x[r + 8];
            u32x2 o; o.x = pk2(sw[0] * inv - bf2f(cw.x & 0xffff), sw[1] * inv - bf2f(cw.x >> 16)); o.y = pk2(sw[2] * inv - bf2f(cw.y & 0xffff), sw[3] * inv - bf2f(cw.y >> 16));
            *(u32x2*)(AG + (size_t)m * 384 + 128 + lane * 4) = o;
        }
    }
}
__device__ __forceinline__ void scan_pos(int d, int u, int& m, bool& hp, bool& hn) {
    if (u < TC) { const int t = d ? (TC - 1 - u) : u; m = TL + t; hp = t > 0; hn = t < TC - 1; }
    else { const int t = d ? (TL - 1 - (u - TC)) : (u - TC); m = t; hp = t > 0; hn = t < TL - 1; }
}
__device__ __forceinline__ int lane_id() { return __builtin_amdgcn_mbcnt_hi(~0u, __builtin_amdgcn_mbcnt_lo(~0u, 0u)); }
constexpr int SH_OFF = 8 * WAVE_LDS, SH_W2 = SH_OFF, SH_A2 = SH_OFF + 9216, SH_CST = SH_OFF + 18432, SH_MU = SH_CST + 1280;
__device__ __forceinline__ void scan_setup(const Args& a, int h, int d, unsigned char* lds) {
    const int tid = threadIdx.x;
    const bf16_t* wb = (const bf16_t*)a.out;
    const bf16_t* w2 = wb + WO_W2T / 2 + (size_t)(d * DA + h * 64) * 64; const bf16_t* a2 = wb + WO_A2T / 2 + (size_t)(d * DA + h * 64) * 64;
    { const int n = tid >> 3, c8 = tid & 7; *(u32x4*)(lds + SH_W2 + (n * 72 + c8 * 8) * 2) = *(const u32x4*)(w2 + n * 64 + c8 * 8); *(u32x4*)(lds + SH_A2 + (n * 72 + c8 * 8) * 2) = *(const u32x4*)(a2 + n * 64 + c8 * 8); }
    if (tid < 320) { const int which = tid >> 6, ch = tid & 63; float v;
        if (which == 0) v = a.in[13][d * DA + h * 64 + ch]; else if (which == 1) v = a.in[15][d * DA + h * 64 + ch]; else if (which == 2) v = a.in[18][h * 64 + ch]; else if (which == 3) v = a.in[19][h * 64 + ch]; else v = a.in[20][h * 64 + ch];
        ((float*)(lds + SH_CST))[which * 64 + (ch & 15) * 4 + (ch >> 4)] = v; }
    for (int i = tid; i < 640; i += 512) { const int cg = i >> 7, sel = (i >> 6) & 1, ch = i & 63;
        const int col = (cg == 0 ? h * 64 : cg == 1 ? 768 + h * 64 : cg == 2 ? 1536 + h * 64 : cg == 3 ? 2304 + d * 64 : 2432 + d * 64) + ch;
        ((float*)(lds + SH_MU))[i] = a.in[12][sel * 2688 + col]; }
    __syncthreads();
}
#define SB __builtin_amdgcn_sched_barrier(0)
struct Raw { unsigned short v[5][10]; };
#ifndef PFA
#define PFA 3
#endif
__device__ __forceinline__ void prep_geom(int d, int u0, int& mlo, int& seq_first, int& seq_last) {
    const bool isctx = u0 < TC;
    seq_first = isctx ? TL : 0; seq_last = isctx ? TL + TC - 1 : TL - 1;
    const int mu0 = isctx ? TL + (d ? TC - 1 - u0 : u0) : (d ? TL - 1 - (u0 - TC) : u0 - TC);
    mlo = d ? mu0 - 7 : mu0;
}
template <int C0, int C1>
__device__ __forceinline__ void prep_load(const bf16_t* __restrict__ P, int h, int d, int u0, Raw& raw) {
    const int lane = lane_id();
    int mlo, seq_first, seq_last; prep_geom(d, u0, mlo, seq_first, seq_last);
    const int cols[5] = {h * 64 + lane, 768 + h * 64 + lane, 1536 + h * 64 + lane, 2304 + d * 64 + lane, 2432 + d * 64 + lane};
#pragma unroll
    for (int j = 0; j < 10; ++j) { const int row = min(max(mlo - 1 + j, seq_first), seq_last); const bf16_t* rp = P + (size_t)row * PLD;
#pragma unroll
        for (int c = C0; c < C1; ++c) raw.v[c][j] = rp[cols[c]]; }
}
template <bool COEF>
__device__ __forceinline__ void scan_prep(const Raw& raw, int h, int d, int u0, float* L, bf16_t* At, const unsigned char* lds, float* coef_d) {
    __builtin_amdgcn_s_setprio(3);
    const int lane = lane_id(); const int l16 = lane & 15, quad = lane >> 4;
    int mlo, seq_first, seq_last; prep_geom(d, u0, mlo, seq_first, seq_last);
    const bool okp = (mlo - 1 >= seq_first), okn = (mlo + 8 <= seq_last);
    const float* mul = (const float*)(lds + SH_MU);
#pragma unroll
    for (int c = 0; c < 5; ++c) {
        const float m0 = mul[(c * 2 + 0) * 64 + lane], m1 = mul[(c * 2 + 1) * 64 + lane];
#pragma unroll
        for (int jj = 1; jj <= 8; ++jj) {
            const int tt = d ? 8 - jj : jj - 1;
            const float cur = bf2f(raw.v[c][jj]); float pv = bf2f(raw.v[c][jj - 1]), nx = bf2f(raw.v[c][jj + 1]);
            if (jj == 1) pv = okp ? pv : 0.f;
            if (jj == 8) nx = okn ? nx : 0.f;
            const float mx = cur + (pv - cur) * m0 + (nx - cur) * m1;
            if (c == 0) L[(tt * 6 + 4) * 64 + (lane & 15) * 4 + (lane >> 4)] = mx;
            else if (c == 1) L[(tt * 6 + 2) * 64 + (lane & 15) * 4 + (lane >> 4)] = mx;
            else if (c == 2) L[(tt * 6 + 5) * 64 + lane] = mx;
            else if (c == 3) { const float e2 = __expf(2.f * mx); const bf16_t tb = (bf16_t)f2bf(1.f - 2.f * rcp_(e2 + 1.f)); At[tt * 72 + lane] = tb; At[(tt + 8) * 72 + lane] = tb; }
            else { const bf16_t ab = (bf16_t)f2bf(mx); At[16 * 72 + tt * 72 + lane] = ab; At[16 * 72 + (tt + 8) * 72 + lane] = ab; }
        }
    }
    if (lane < 8) *(int*)(At + lane * 72 + 64) = d ? mlo + 7 - lane : mlo + lane;
    wave_sync();
    f32x4 accw[4], acca[4];
#pragma unroll
    for (int nt = 0; nt < 4; ++nt) { accw[nt] = (f32x4){0.f, 0.f, 0.f, 0.f}; acca[nt] = (f32x4){0.f, 0.f, 0.f, 0.f}; }
    const bf16_t* W2l = (const bf16_t*)(lds + SH_W2); const bf16_t* A2l = (const bf16_t*)(lds + SH_A2);
#pragma unroll
    for (int ks = 0; ks < 2; ++ks) {
        const bf16x8 aw = *(const bf16x8*)(At + l16 * 72 + ks * 32 + quad * 8), aa = *(const bf16x8*)(At + 16 * 72 + l16 * 72 + ks * 32 + quad * 8);
#pragma unroll
        for (int nt = 0; nt < 4; ++nt) {
            const bf16x8 bw = *(const bf16x8*)(W2l + (nt * 16 + l16) * 72 + ks * 32 + quad * 8), ba = *(const bf16x8*)(A2l + (nt * 16 + l16) * 72 + ks * 32 + quad * 8);
            accw[nt] = __builtin_amdgcn_mfma_f32_16x16x32_bf16(aw, bw, accw[nt], 0, 0, 0); acca[nt] = __builtin_amdgcn_mfma_f32_16x16x32_bf16(aa, ba, acca[nt], 0, 0, 0);
        }
    }
    const float* cst = (const float*)(lds + SH_CST);
    const bool hi = quad >= 2; const int ntb = hi ? 2 : 0;
    f32x4 aw[2], aa[2];
    aw[0] = hi ? accw[2] : accw[0]; aw[1] = hi ? accw[3] : accw[1]; aa[0] = hi ? acca[2] : acca[0]; aa[1] = hi ? acca[3] : acca[1];
#pragma unroll
    for (int j = 0; j < 4; ++j) {
        SB;
        const int o2 = l16 * 4 + ntb;
        const f32x2 cw0 = *(const f32x2*)(cst + o2), ca0 = *(const f32x2*)(cst + 64 + o2), ckk = *(const f32x2*)(cst + 128 + o2), cka = *(const f32x2*)(cst + 192 + o2), crk = *(const f32x2*)(cst + 256 + o2);
        const int tok = (quad & 1) * 4 + j;
        const f32x2 kv = *(const f32x2*)(L + (tok * 6 + 2) * 64 + o2), rv = *(const f32x2*)(L + (tok * 6 + 4) * 64 + o2);
        const f32x2 kkv = kv * ckk;
        float ss = xsum32(sum16(kkv[0] * kkv[0] + kkv[1] * kkv[1]));
        const float inv = __builtin_amdgcn_rsqf(fmaxf(ss, 1e-24f));
        float cs = 0.f; f32x2 o_w, o_b, o_kd, o_kk;
#pragma unroll
        for (int e = 0; e < 2; ++e) {
            o_w[e] = __expf(-0.60653066f * sigm(cw0[e] + aw[e][j]));
            const float av = sigm(ca0[e] + aa[e][j]);
            o_kk[e] = kkv[e] * inv; o_b[e] = o_kk[e] * av; o_kd[e] = kv[e] * (1.f + (av - 1.f) * cka[e]);
            if (COEF) cs += rv[e] * o_kd[e] * crk[e];
        }
        { const int n0 = ntb * 16 + l16;
          L[(tok * 6 + 0) * 64 + n0] = o_w[0]; L[(tok * 6 + 0) * 64 + n0 + 16] = o_w[1]; L[(tok * 6 + 1) * 64 + n0] = o_b[0]; L[(tok * 6 + 1) * 64 + n0 + 16] = o_b[1];
          L[(tok * 6 + 2) * 64 + n0] = o_kd[0]; L[(tok * 6 + 2) * 64 + n0 + 16] = o_kd[1]; }
        *(f32x2*)(L + (tok * 6 + 3) * 64 + o2) = o_kk;
        if (COEF) { cs = xsum32(sum16(cs)); if (lane < 32 && l16 == 0) { const int m = *(const int*)(At + tok * 72 + 64); coef_d[(size_t)m * 12 + h] = cs; } }
    }
    wave_sync();
    __builtin_amdgcn_s_setprio(0);
}
#define FMAC_K(acc, X, Sv, K) asm volatile("v_fmac_f32_dpp %0, %1, %2 row_newbcast:" #K " row_mask:0xf bank_mask:0xf" : "+v"(acc) : "v"(X), "v"(Sv))
#define MULIP_K(Sv, X, K) asm volatile("v_mul_f32_dpp %0, %1, %0 row_newbcast:" #K " row_mask:0xf bank_mask:0xf" : "+v"(Sv) : "v"(X))
#define K16(M) M(0) M(1) M(2) M(3) M(4) M(5) M(6) M(7) M(8) M(9) M(10) M(11) M(12) M(13) M(14) M(15)
#ifndef DEPC_
#define DEPC_ 3
#endif
#ifndef DEPA_
#define DEPA_ 2
#endif
struct TokVec { f32x4 kk, r; float v; };
__device__ __forceinline__ void tok_load(TokVec& t, const float* V, int lane_unused, bool need_r) {
    const int lane = lane_id(); const int o = (lane & 15) * 4;
    t.kk = *(const f32x4*)(V + 192 + o);
    if (need_r) t.r = *(const f32x4*)(V + 256 + o);
    t.v = V[320 + lane];
}
#define F2(v, i) ((f32x2){(v)[2 * (i)], (v)[2 * (i) + 1]})
#define SPn(n) SP[(n) >> 1][(n) & 1]
#define SQn(n) SQ[(n) >> 1][(n) & 1]
#define SSn(n) S[(n) >> 1][(n) & 1]
#define A_DOT(k) FMAC_K(ap0, kk0, SPn(k), k); FMAC_K(ap1, kk1, SPn(16 + k), k); FMAC_K(ap2, kk2, SPn(32 + k), k); FMAC_K(ap3, kk3, SPn(48 + k), k); \
                 FMAC_K(aq0, kk0, SQn(k), k); FMAC_K(aq1, kk1, SQn(16 + k), k); FMAC_K(aq2, kk2, SQn(32 + k), k); FMAC_K(aq3, kk3, SQn(48 + k), k);
__device__ __forceinline__ void scan_passA(const Args& a, unsigned char* lds) {
    const int lane = threadIdx.x & 63, wave = __builtin_amdgcn_readfirstlane(threadIdx.x >> 6);
    if ((int)blockIdx.x * 8 >= 24 * NC) return;
    const int item = blockIdx.x * 8 + wave, hd = (blockIdx.x * 8) / NC, cidx = item % NC, h = hd >> 1, d = hd & 1;
    scan_setup(a, h, d, lds);
    float* L = (float*)(lds + wave * WAVE_LDS); bf16_t* At = (bf16_t*)(lds + wave * WAVE_LDS + NS * 6 * 64 * 4);
    const bf16_t* P = (const bf16_t*)(a.ws + OFF_PBUF);
    f32x2 SP[32], SQ[32];
#pragma unroll
    for (int q = 0; q < 32; ++q) { SP[q] = (f32x2){(2 * q == lane) ? 1.f : 0.f, (2 * q + 1 == lane) ? 1.f : 0.f}; SQ[q] = (f32x2){0.f, 0.f}; }
    Raw raw; prep_load<0, PFA>(P, h, d, cidx * CH, raw);
#pragma unroll 1
    for (int g = 0; g < CH / NS; ++g) {
        prep_load<PFA, 5>(P, h, d, cidx * CH + g * NS, raw);
        scan_prep<false>(raw, h, d, cidx * CH + g * NS, L, At, lds, nullptr);
        prep_load<0, PFA>(P, h, d, cidx * CH + min(g + 1, CH / NS - 1) * NS, raw);
#pragma unroll 1
        for (int tt = 0; tt < NS; ++tt) {
            const float* V = L + tt * 384;
            TokVec TA; tok_load(TA, V, lane, false);
            constexpr int DEPA = DEPA_;
            f32x4 ub[DEPA + 1][3];
#define A_ISSUE(qi) { ub[(qi) % (DEPA + 1)][0] = *(const f32x4*)(V + (qi) * 4); ub[(qi) % (DEPA + 1)][1] = *(const f32x4*)(V + 64 + (qi) * 4); ub[(qi) % (DEPA + 1)][2] = *(const f32x4*)(V + 128 + (qi) * 4); }
#pragma unroll
            for (int qi = 0; qi < DEPA; ++qi) A_ISSUE(qi)
            SB;
            const float kk0 = TA.kk[0], kk1 = TA.kk[1], kk2 = TA.kk[2], kk3 = TA.kk[3], vv = TA.v;
            float ap0 = 0.f, ap1 = 0.f, ap2 = 0.f, ap3 = 0.f, aq0 = 0.f, aq1 = 0.f, aq2 = 0.f, aq3 = 0.f;
            K16(A_DOT)
            const float sap = -((ap0 + ap1) + (ap2 + ap3)), saq = -((aq0 + aq1) + (aq2 + aq3));
            const f32x2 sap2 = (f32x2){sap, sap}, saq2 = (f32x2){saq, saq}, v2 = (f32x2){vv, vv};
#pragma unroll
            for (int q = 0; q < 16; ++q) {
                if (q + DEPA < 16) A_ISSUE(q + DEPA)
                SB;
                { const f32x4 w4 = ub[q % (DEPA + 1)][0], b4 = ub[q % (DEPA + 1)][1], d4 = ub[q % (DEPA + 1)][2];
                    SP[2 * q] = SP[2 * q] * F2(w4, 0) + sap2 * F2(b4, 0); SP[2 * q + 1] = SP[2 * q + 1] * F2(w4, 1) + sap2 * F2(b4, 1);
                    SQ[2 * q] = SQ[2 * q] * F2(w4, 0) + (saq2 * F2(b4, 0) + v2 * F2(d4, 0)); SQ[2 * q + 1] = SQ[2 * q + 1] * F2(w4, 1) + (saq2 * F2(b4, 1) + v2 * F2(d4, 1)); }
                SB;
            }
        }
        wave_sync();
    }
    float* PQ = (float*)(a.ws + OFF_PQ) + (size_t)item * 8192; const int lane2 = lane_id();
#pragma unroll
    for (int q = 0; q < 16; ++q) { *(f32x4*)(PQ + lane2 * 64 + q * 4) = (f32x4){SP[2 * q][0], SP[2 * q][1], SP[2 * q + 1][0], SP[2 * q + 1][1]};
        *(f32x4*)(PQ + 4096 + lane2 * 64 + q * 4) = (f32x4){SQ[2 * q][0], SQ[2 * q][1], SQ[2 * q + 1][0], SQ[2 * q + 1][1]}; }
}
__device__ __forceinline__ void scan_passB(const Args& a, unsigned char* lds) {
    const int tid = threadIdx.x, b = blockIdx.x, hd = b >> 3, rg = b & 7, il = tid >> 6, n = tid & 63, i = rg * 8 + il;
    float* Sl = (float*)lds;
    float* Pl = Sl + 1024;
    float* base = (float*)(a.ws + OFF_PQ) + (size_t)hd * NC * 8192;
    Sl[tid] = 0.f;
    f32x4 p0 = *(const f32x4*)(base + tid * 8), p1 = *(const f32x4*)(base + tid * 8 + 4);
    *(f32x4*)(Pl + tid * 8) = p0; *(f32x4*)(Pl + tid * 8 + 4) = p1;
    float q = base[4096 + i * 64 + n], qn = 0.f;
    if (NC > 2) { p0 = *(const f32x4*)(base + 8192 + tid * 8); p1 = *(const f32x4*)(base + 8192 + tid * 8 + 4); qn = base[8192 + 4096 + i * 64 + n]; }
    __syncthreads();
    for (int c = 0; c < NC - 1; ++c) {
        const int cur = c & 1;
        const float* Sc = Sl + cur * 512 + il * 64; const float* Pc = Pl + cur * 4096 + n;
        float acc0 = q, acc1 = 0.f;
#pragma unroll
        for (int m = 0; m < 64; m += 4) { const f32x4 s4 = *(const f32x4*)(Sc + m);
            acc0 += s4[0] * Pc[(m + 0) * 64]; acc1 += s4[1] * Pc[(m + 1) * 64]; acc0 += s4[2] * Pc[(m + 2) * 64]; acc1 += s4[3] * Pc[(m + 3) * 64]; }
        const float acc = acc0 + acc1;
        Sl[(cur ^ 1) * 512 + il * 64 + n] = acc; base[(size_t)c * 8192 + 4096 + i * 64 + n] = acc;
        *(f32x4*)(Pl + (cur ^ 1) * 4096 + tid * 8) = p0; *(f32x4*)(Pl + (cur ^ 1) * 4096 + tid * 8 + 4) = p1; q = qn;
        if (c + 2 < NC - 1) { const float* nb = base + (size_t)(c + 2) * 8192; p0 = *(const f32x4*)(nb + tid * 8); p1 = *(const f32x4*)(nb + tid * 8 + 4); qn = nb[4096 + i * 64 + n]; }
        __syncthreads();
    }
}
#define C_DOT(k) FMAC_K(aq0, kk0, SSn(k), k); FMAC_K(aq1, kk1, SSn(16 + k), k); FMAC_K(aq2, kk2, SSn(32 + k), k); FMAC_K(aq3, kk3, SSn(48 + k), k);
#define C_Y(k) FMAC_K(ya0, r0, SSn(k), k); FMAC_K(ya1, r1, SSn(16 + k), k); FMAC_K(ya2, r2, SSn(32 + k), k); FMAC_K(ya3, r3, SSn(48 + k), k);
__device__ __forceinline__ void scan_passC(const Args& a, unsigned char* lds) {
    const int lane = threadIdx.x & 63, wave = __builtin_amdgcn_readfirstlane(threadIdx.x >> 6);
    if ((int)blockIdx.x * 8 >= 24 * NC) return;
    const int item = blockIdx.x * 8 + wave, hd = (blockIdx.x * 8) / NC, cidx = item % NC, h = hd >> 1, d = hd & 1;
    scan_setup(a, h, d, lds);
    float* L = (float*)(lds + wave * WAVE_LDS); bf16_t* At = (bf16_t*)(lds + wave * WAVE_LDS + NS * 6 * 64 * 4);
    const bf16_t* P = (const bf16_t*)(a.ws + OFF_PBUF);
    bf16_t* Y = (bf16_t*)(a.ws + OFF_Y) + (size_t)d * T * DA; float* coef_d = (float*)(a.ws + OFF_COEF) + (size_t)d * T * 12;
    f32x2 S[32];
    if (cidx > 0) { const float* S0 = (const float*)(a.ws + OFF_PQ) + (size_t)(item - 1) * 8192 + 4096 + lane * 64;
#pragma unroll
        for (int q = 0; q < 16; ++q) { const f32x4 s4 = *(const f32x4*)(S0 + q * 4); S[2 * q] = (f32x2){s4[0], s4[1]}; S[2 * q + 1] = (f32x2){s4[2], s4[3]}; } }
    else {
#pragma unroll
        for (int q = 0; q < 32; ++q) S[q] = (f32x2){0.f, 0.f}; }
#pragma unroll 1
    for (int g = 0; g < CH / NS; ++g) {
        const int u0 = cidx * CH + g * NS;
        { Raw raw; prep_load<0, 5>(P, h, d, u0, raw); scan_prep<true>(raw, h, d, u0, L, At, lds, coef_d); }
#pragma unroll 1
        for (int tt = 0; tt < NS; ++tt) {
            const float* V = L + tt * 384;
            TokVec TA; tok_load(TA, V, lane, true);
            const int m0 = *(const int*)(At + tt * 72 + 64);
            constexpr int DEP = DEPC_;
            f32x4 ub[DEP + 1][2][3];
#define C_ISSUE(bb) { _Pragma("unroll") for (int qq = 0; qq < 2; ++qq) { const int q_ = (bb) * 2 + qq; ub[(bb) % (DEP + 1)][qq][0] = *(const f32x4*)(V + q_ * 4); ub[(bb) % (DEP + 1)][qq][1] = *(const f32x4*)(V + 64 + q_ * 4); ub[(bb) % (DEP + 1)][qq][2] = *(const f32x4*)(V + 128 + q_ * 4); } }
#pragma unroll
            for (int bb = 0; bb < DEP; ++bb) C_ISSUE(bb)
            SB;
            const float kk0 = TA.kk[0], kk1 = TA.kk[1], kk2 = TA.kk[2], kk3 = TA.kk[3], r0 = TA.r[0], r1 = TA.r[1], r2 = TA.r[2], r3 = TA.r[3], vv = TA.v;
            float aq0 = 0.f, aq1 = 0.f, aq2 = 0.f, aq3 = 0.f;
            K16(C_DOT)
            const float sa = -((aq0 + aq1) + (aq2 + aq3));
            const f32x2 sa2 = (f32x2){sa, sa}, v2 = (f32x2){vv, vv};
#pragma unroll
            for (int b = 0; b < 8; ++b) {
                if (b + DEP < 8) C_ISSUE(b + DEP)
                SB;
#pragma unroll
                for (int qq = 0; qq < 2; ++qq) { const int q = b * 2 + qq; const f32x4 w4 = ub[b % (DEP + 1)][qq][0], b4 = ub[b % (DEP + 1)][qq][1], d4 = ub[b % (DEP + 1)][qq][2];
                    S[2 * q] = S[2 * q] * F2(w4, 0) + (sa2 * F2(b4, 0) + v2 * F2(d4, 0)); S[2 * q + 1] = S[2 * q + 1] * F2(w4, 1) + (sa2 * F2(b4, 1) + v2 * F2(d4, 1)); }
                SB;
            }
            float ya0 = 0.f, ya1 = 0.f, ya2 = 0.f, ya3 = 0.f;
            K16(C_Y)
            { const int ln = lane_id(); Y[(size_t)m0 * DA + h * 64 + ln] = (bf16_t)f2bf((ya0 + ya1) + (ya2 + ya3)); }
        }
        wave_sync();
    }
}
__device__ __forceinline__ void readout_rows(const Args& a) {
    const int lane = threadIdx.x & 63, wave = threadIdx.x >> 6, hg = lane >> 4, sub = lane & 15;
    const bf16_t* P = (const bf16_t*)(a.ws + OFF_PBUF); const bf16_t* Y = (const bf16_t*)(a.ws + OFF_Y); const float* CO = (const float*)(a.ws + OFF_COEF);
    bf16_t* H = (bf16_t*)(a.ws + OFF_HBUF);
#pragma unroll 2
    for (int m = blockIdx.x * 8 + wave; m < T; m += gridDim.x * 8) {
        const int s0 = m < TL ? 0 : TL, len = m < TL ? TL : TC, t = m - s0; const bool hp = t > 0, hn = t < len - 1;
        const bf16_t* row = P + (size_t)m * PLD;
#pragma unroll
        for (int hq = 0; hq < 3; ++hq) {
            const int h = hq * 4 + hg, ch = h * 64 + sub * 4, vc = 1536 + ch;
            const u32x2 y0 = *(const u32x2*)(Y + (size_t)m * DA + ch), y1 = *(const u32x2*)(Y + (size_t)(T + m) * DA + ch);
            const u32x2 pc = *(const u32x2*)(row + vc); const u32x2 pp = hp ? *(const u32x2*)(row + vc - PLD) : (u32x2){0u, 0u}; const u32x2 pn = hn ? *(const u32x2*)(row + vc + PLD) : (u32x2){0u, 0u};
            const u32x2 gw = *(const u32x2*)(H + (size_t)m * D + ch);
            const f32x4 lg = *(const f32x4*)(a.in[21] + ch), lb = *(const f32x4*)(a.in[22] + ch), m0 = *(const f32x4*)(a.in[12] + vc), m1 = *(const f32x4*)(a.in[12] + 2688 + vc);
            const float coef = CO[(size_t)m * 12 + h] + CO[(size_t)(T + m) * 12 + h];
            float y[4] = {bf2f(y0.x & 0xffff) + bf2f(y1.x & 0xffff), bf2f(y0.x >> 16) + bf2f(y1.x >> 16), bf2f(y0.y & 0xffff) + bf2f(y1.y & 0xffff), bf2f(y0.y >> 16) + bf2f(y1.y >> 16)};
            const float cu[4] = {bf2f(pc.x & 0xffff), bf2f(pc.x >> 16), bf2f(pc.y & 0xffff), bf2f(pc.y >> 16)};
            const float pv[4] = {bf2f(pp.x & 0xffff), bf2f(pp.x >> 16), bf2f(pp.y & 0xffff), bf2f(pp.y >> 16)};
            const float nx[4] = {bf2f(pn.x & 0xffff), bf2f(pn.x >> 16), bf2f(pn.y & 0xffff), bf2f(pn.y >> 16)};
            const float g[4] = {bf2f(gw.x & 0xffff), bf2f(gw.x >> 16), bf2f(gw.y & 0xffff), bf2f(gw.y >> 16)};
            const float mu = sum16((y[0] + y[1]) + (y[2] + y[3])) * (1.f / 64.f);
            float q = 0.f;
#pragma unroll
            for (int e = 0; e < 4; ++e) { y[e] -= mu; q += y[e] * y[e]; }
            const float rstd = rsqrtf(sum16(q) * (1.f / 64.f) + GN_EPS);
            float o[4];
#pragma unroll
            for (int e = 0; e < 4; ++e) { const float v = cu[e] + (pv[e] - cu[e]) * m0[e] + (nx[e] - cu[e]) * m1[e]; o[e] = (y[e] * rstd * lg[e] + lb[e] + coef * v) * g[e]; }
            u32x2 w; w.x = pk2(o[0], o[1]); w.y = pk2(o[2], o[3]);
            *(u32x2*)(H + (size_t)m * D + ch) = w;
        }
    }
}
constexpr int NA_KC = 0, NA_VC = 36864, NA_RPB = 36864 + 33792;
template <int HALF, int KSTRIDE, int VSTRIDE>
__device__ __forceinline__ void natten_half(const bf16_t* __restrict__ kbase, const bf16_t* __restrict__ vbase, const float* __restrict__ rpbh, const bf16x8 q0, const bf16x8 q1,
                                            int quad, int kr0, int kc0, int sc, f32x4 (&o)[4], float& mrun, float& lrun) {
#define KOFF(kt) (HALF ? (kt) * 16 : (((kt) >> 1) * 64 + ((kt) & 1) * 16))
    f32x4 s[16];
    {
        bf16x8 kf[16][2];
        const bf16_t* kp = kbase;
#pragma unroll
        for (int kt = 0; kt < 16; ++kt) { kf[kt][0] = *(const bf16x8*)kp; kf[kt][1] = *(const bf16x8*)(kp + 32); kp += (size_t)(KOFF(kt + 1) - KOFF(kt)) * KSTRIDE; }
        SB;
#pragma unroll
        for (int kt = 0; kt < 16; ++kt) { f32x4 z = (f32x4){0.f, 0.f, 0.f, 0.f};
            z = __builtin_amdgcn_mfma_f32_16x16x32_bf16(kf[kt][0], q0, z, 0, 0, 0); s[kt] = __builtin_amdgcn_mfma_f32_16x16x32_bf16(kf[kt][1], q1, z, 0, 0, 0); }
        SB;
    }
    u32x2 vf[8][4][2];
#pragma unroll
    for (int kp2 = 0; kp2 < 8; ++kp2)
#pragma unroll
        for (int dt = 0; dt < 4; ++dt) { const bf16_t* vp = vbase + (size_t)dt * 16 * VSTRIDE; vf[kp2][dt][0] = *(const u32x2*)(vp + KOFF(2 * kp2)); vf[kp2][dt][1] = *(const u32x2*)(vp + KOFF(2 * kp2 + 1)); }
    SB;
    float mx = -1e30f;
#pragma unroll
    for (int kt = 0; kt < 16; ++kt)
#pragma unroll
        for (int j = 0; j < 4; ++j) {
            float v = s[kt][j] * 0.125f;
            if (HALF == 0) { const int kc = kc0 + (kt & 1) * 16 + j; const bool ok = (kc >= sc) && (kc < sc + 16);
                if (ok) v += rpbh[(kr0 + (kt >> 1)) * 31 + kc]; else v = -1e30f; }
            s[kt][j] = v; mx = fmaxf(mx, v);
        }
    mx = fmaxf(mx, __shfl_xor(mx, 16)); mx = fmaxf(mx, __shfl_xor(mx, 32));
    const float mnew = fmaxf(mrun, mx), resc = __expf(mrun - mnew);
    float sm = 0.f;
#pragma unroll
    for (int kt = 0; kt < 16; ++kt)
#pragma unroll
        for (int j = 0; j < 4; ++j) { const float e = __expf(s[kt][j] - mnew); s[kt][j] = e; sm += e; }
    sm += __shfl_xor(sm, 16); sm += __shfl_xor(sm, 32);
    lrun = lrun * resc + sm; mrun = mnew;
#pragma unroll
    for (int j = 0; j < 4; ++j) { const float rj = __shfl(resc, quad * 4 + j);
#pragma unroll
        for (int dt = 0; dt < 4; ++dt) o[dt][j] *= rj; }
    SB;
#pragma unroll
    for (int kp2 = 0; kp2 < 8; ++kp2) {
        const int ka = 2 * kp2, kb = 2 * kp2 + 1;
        u32x4 pw; pw.x = pk2(s[ka][0], s[ka][1]); pw.y = pk2(s[ka][2], s[ka][3]); pw.z = pk2(s[kb][0], s[kb][1]); pw.w = pk2(s[kb][2], s[kb][3]);
        const bf16x8 pa = __builtin_bit_cast(bf16x8, pw);
#pragma unroll
        for (int dt = 0; dt < 4; ++dt) {
            u32x4 vw; vw.x = vf[kp2][dt][0].x; vw.y = vf[kp2][dt][0].y; vw.z = vf[kp2][dt][1].x; vw.w = vf[kp2][dt][1].y;
            o[dt] = __builtin_amdgcn_mfma_f32_16x16x32_bf16(pa, __builtin_bit_cast(bf16x8, vw), o[dt], 0, 0, 0);
        }
    }
    SB;
#undef KOFF
}
#define NA_BLOCK(t, BIAS) { \
    f32x4 sA = (f32x4){0.f, 0.f, 0.f, 0.f}, sB = (f32x4){0.f, 0.f, 0.f, 0.f}; \
    sA = __builtin_amdgcn_mfma_f32_16x16x32_bf16(kA0, qa[t], sA, 0, 0, 0); sA = __builtin_amdgcn_mfma_f32_16x16x32_bf16(kA1, qb[t], sA, 0, 0, 0); \
    sB = __builtin_amdgcn_mfma_f32_16x16x32_bf16(kB0, qa[t], sB, 0, 0, 0); sB = __builtin_amdgcn_mfma_f32_16x16x32_bf16(kB1, qb[t], sB, 0, 0, 0); \
    float v_[8]; \
    _Pragma("unroll") for (int j = 0; j < 4; ++j) { v_[j] = sA[j] * 0.125f; v_[4 + j] = sB[j] * 0.125f; } \
    if (BIAS) { const float* rb_ = rpbl + (kr - (r0 + t) + 7) * 31 + (15 - cq); \
        _Pragma("unroll") for (int j = 0; j < 4; ++j) { const int kcA = cbase + quad * 4 + j, kcB = kcA + 16; \
            v_[j] = (kcA >= sc && kcA < sc + 16) ? v_[j] + rb_[kcA] : -1e30f; v_[4 + j] = (kcB >= sc && kcB < sc + 16) ? v_[4 + j] + rb_[kcB] : -1e30f; } } \
    float bm_ = fmaxf(fmaxf(fmaxf(v_[0], v_[1]), fmaxf(v_[2], v_[3])), fmaxf(fmaxf(v_[4], v_[5]), fmaxf(v_[6], v_[7]))); \
    if (__any(bm_ > mref[t] + 8.f)) { bm_ = xmax32(xmax16(bm_));     \
        const bool need_ = bm_ > mref[t] + 8.f; const float mn_ = need_ ? bm_ : mref[t]; const float rs_ = __expf(mref[t] - mn_); lsum[t] *= rs_; mref[t] = mn_; \
        _Pragma("unroll") for (int j = 0; j < 4; ++j) { const float rj_ = __shfl(rs_, quad * 4 + j); \
            _Pragma("unroll") for (int dt = 0; dt < 4; ++dt) o[t][dt][j] *= rj_; } } \
    float ps_ = 0.f; \
    _Pragma("unroll") for (int i = 0; i < 8; ++i) { v_[i] = __expf(v_[i] - mref[t]); ps_ += v_[i]; } \
    lsum[t] += ps_;     \
    u32x4 pw_; pw_.x = pk2(v_[0], v_[1]); pw_.y = pk2(v_[2], v_[3]); pw_.z = pk2(v_[4], v_[5]); pw_.w = pk2(v_[6], v_[7]); \
    const bf16x8 pa_ = __builtin_bit_cast(bf16x8, pw_); \
    _Pragma("unroll") for (int dt = 0; dt < 4; ++dt) o[t][dt] = __builtin_amdgcn_mfma_f32_16x16x32_bf16(pa_, vfr[dt], o[t][dt], 0, 0, 0); }
__device__ __forceinline__ void natten(const Args& a, unsigned char* lds) {
    const int tid = threadIdx.x, lane = tid & 63, wave = __builtin_amdgcn_readfirstlane(tid >> 6), l16 = lane & 15, quad = lane >> 4;
    const bf16_t* QK = (const bf16_t*)(a.ws + OFF_QK); const bf16_t* Vt = (const bf16_t*)(a.ws + OFF_VT); bf16_t* O = (bf16_t*)(a.ws + OFF_HBUF);
    const int h = blockIdx.x & 15, rb = blockIdx.x >> 4;
    bf16_t* Kc = (bf16_t*)(lds + NA_KC); bf16_t* Vc = (bf16_t*)(lds + NA_VC); float* rpbl = (float*)(lds + NA_RPB);
    for (int i = tid; i < 2048; i += 512) { const int t = i >> 3, c8 = i & 7; *(u32x4*)(Kc + t * 72 + c8 * 8) = *(const u32x4*)(QK + (size_t)(TL + t) * 2048 + 1024 + h * 64 + c8 * 8);
        const int dd = i >> 5, c32 = i & 31; *(u32x4*)(Vc + dd * 264 + c32 * 8) = *(const u32x4*)(Vt + (size_t)(h * 64 + dd) * T + TL + c32 * 8); }
    if (tid < 465) rpbl[tid] = a.in[27][h * 465 + tid];
    __syncthreads();
#pragma unroll 1
    for (int jt = wave; jt < 16; jt += 8) {
        const int cgi = jt & 3, r0 = (rb * 4 + (jt >> 2)) * 4, c0 = cgi * 16, cbase = min(max(c0 - 8, 0), 32);
        const int cq = c0 + l16, sc = min(max(cq - 8, 0), 48);
        bf16x8 qa[4], qb[4];
#pragma unroll
        for (int t = 0; t < 4; ++t) { const bf16_t* qp = QK + (size_t)((r0 + t) * 64 + c0 + l16) * 2048 + h * 64 + quad * 8; qa[t] = *(const bf16x8*)qp; qb[t] = *(const bf16x8*)(qp + 32); }
        f32x4 o[4][4]; float mref[4], lsum[4];
#pragma unroll
        for (int t = 0; t < 4; ++t) { mref[t] = -1e30f; lsum[t] = 0.f;
#pragma unroll
            for (int dt = 0; dt < 4; ++dt) o[t][dt] = (f32x4){0.f, 0.f, 0.f, 0.f}; }
        const int krlo = min(max(r0 - 4, 0), 248), krhi = min(max(r0 + 3 - 4, 0), 248) + 7;
        bf16x8 nA0, nA1, nB0, nB1; u32x2 nva[4], nvb[4];
#define NA_LOADKV(krx) { const int tk_ = (krx) * 64 + cbase; const bf16_t* kp_ = QK + (size_t)(tk_ + l16) * 2048 + 1024 + h * 64 + quad * 8; \
            nA0 = *(const bf16x8*)kp_; nA1 = *(const bf16x8*)(kp_ + 32); nB0 = *(const bf16x8*)(kp_ + 16 * 2048); nB1 = *(const bf16x8*)(kp_ + 16 * 2048 + 32); \
            _Pragma("unroll") for (int dt = 0; dt < 4; ++dt) { const bf16_t* vp_ = Vt + (size_t)(h * 64 + dt * 16 + l16) * T + tk_ + quad * 4; nva[dt] = *(const u32x2*)vp_; nvb[dt] = *(const u32x2*)(vp_ + 16); } }
        NA_LOADKV(krlo)
#pragma unroll 1
        for (int kr = krlo; kr <= krhi; ++kr) {
            const bf16x8 kA0 = nA0, kA1 = nA1, kB0 = nB0, kB1 = nB1;
            bf16x8 vfr[4];
#pragma unroll
            for (int dt = 0; dt < 4; ++dt) { u32x4 vw; vw.x = nva[dt].x; vw.y = nva[dt].y; vw.z = nvb[dt].x; vw.w = nvb[dt].y; vfr[dt] = __builtin_bit_cast(bf16x8, vw); }
            NA_LOADKV(min(kr + 1, krhi))
            SB;
#pragma unroll
            for (int t = 0; t < 4; ++t) { const int srt = min(max(r0 + t - 4, 0), 248); if (kr >= srt && kr <= srt + 7) NA_BLOCK(t, true) }
        }
#define NA_LOADC(kbx) { const bf16_t* kp_ = Kc + ((kbx) * 32 + l16) * 72 + quad * 8; \
            nA0 = *(const bf16x8*)kp_; nA1 = *(const bf16x8*)(kp_ + 32); nB0 = *(const bf16x8*)(kp_ + 16 * 72); nB1 = *(const bf16x8*)(kp_ + 16 * 72 + 32); \
            _Pragma("unroll") for (int dt = 0; dt < 4; ++dt) { const bf16_t* vp_ = Vc + (dt * 16 + l16) * 264 + (kbx) * 32 + quad * 4; nva[dt] = *(const u32x2*)vp_; nvb[dt] = *(const u32x2*)(vp_ + 16); } }
        NA_LOADC(0)
#pragma unroll 1
        for (int kb = 0; kb < 8; ++kb) {
            const int kr = 0; (void)kr;
            const bf16x8 kA0 = nA0, kA1 = nA1, kB0 = nB0, kB1 = nB1;
            bf16x8 vfr[4];
#pragma unroll
            for (int dt = 0; dt < 4; ++dt) { u32x4 vw; vw.x = nva[dt].x; vw.y = nva[dt].y; vw.z = nvb[dt].x; vw.w = nvb[dt].y; vfr[dt] = __builtin_bit_cast(bf16x8, vw); }
            NA_LOADC(min(kb + 1, 7))
            SB;
#pragma unroll
            for (int t = 0; t < 4; ++t) NA_BLOCK(t, false)
        }
#pragma unroll
        for (int t = 0; t < 4; ++t)
#pragma unroll
            for (int j = 0; j < 4; ++j) { const float lt_ = xsum32(xsum16(lsum[t])); const float inv = 1.f / __shfl(lt_, quad * 4 + j);
#pragma unroll
                for (int dt = 0; dt < 4; ++dt) O[(size_t)((r0 + t) * 64 + c0 + quad * 4 + j) * D + h * 64 + dt * 16 + l16] = (bf16_t)f2bf(o[t][dt][j] * inv); }
    }
    __syncthreads();
}
template <class Epi>
__device__ __forceinline__ void run_gemm(unsigned char* lds, const bf16_t* A, const bf16_t* Bt, int M, int N, int K, int G, int c, const Epi& E) {
    pg8::Gemm g{A, Bt, M, N, K, K}; pg8::StaticOrder S; S.init(M, N, G, c);
    pg8::gemm_phase<Epi, pg8::StaticOrder, true, true>((PG8_LAS unsigned char*)lds, g, S, E);
}
template <class Epi>
__device__ __forceinline__ void run_slice(unsigned char* lds, const bf16_t* A, const bf16_t* Bt, int ld, int pn, const Epi& E) {
    pg8::Gemm g{A, Bt, 256, 1024, 256, ld}; OneUnit S{pn};
    pg8::gemm_phase<Epi, OneUnit, true, true>((PG8_LAS unsigned char*)lds, g, S, E);
}
__global__ void __launch_bounds__(512) mega(Args a) {
    extern __shared__ __attribute__((aligned(16))) unsigned char lds[];
    cg::grid_group grid = cg::this_grid();
    { volatile LAS unsigned* st0 = (volatile LAS unsigned*)((LAS unsigned char*)lds + LDS_BAR_OFF); if (threadIdx.x < 4) st0[threadIdx.x] = 0u; }
    __syncthreads();
    XcdBarrier xbar = xcd_barrier_post((unsigned*)(a.ws + OFF_BAR), (volatile LAS unsigned*)((LAS unsigned char*)lds + LDS_BAR_OFF));
    const int lo = a.lo, hi = a.hi, G = gridDim.x, bx = blockIdx.x;
#ifndef PHMASK
#define PHMASK 0x7ffff
#endif
#define IN(k) (((PHMASK >> (k)) & 1) && lo <= (k) && (k) < hi)
#ifndef REPMASK
#define REPMASK 0
#endif
#define REPS(k) for (int rep_ = 0; rep_ < ((((REPMASK) >> (k)) & 1) ? 2 : 1); ++rep_)
#define SEAM(k) do { if (IN(k) && IN((k) + 1)) { if (a.lo < 0) grid.sync(); xcd_barrier(xbar); } } while (0)
    unsigned char* ws = a.ws; const bf16_t* wb = (const bf16_t*)a.out;
    bf16_t* HB = (bf16_t*)(ws + OFF_HBUF); bf16_t* PB = (bf16_t*)(ws + OFF_PBUF); bf16_t* HID = (bf16_t*)(ws + OFF_HID);
    float* Z = (float*)(ws + OFF_Z); float* XA = (float*)(ws + OFF_XA); const float* modr = (const float*)(ws + OFF_MODR);
    const float* lng = a.in[6]; const float* lnb = a.in[7]; float* PART = (float*)((unsigned char*)a.out + WO_PART);
    if (IN(0)) { { phase0(a, lds); } if ((REPMASK >> 0) & 1) { phase0(a, lds); } }
    SEAM(0);
    if (IN(1)) { { phase1(a, lds); } if ((REPMASK >> 1) & 1) { phase1(a, lds); } }
    SEAM(1);
    if (IN(2)) { { run_gemm(lds, HB, wb + WO_WIN0 / 2, T, 3072, 1024, G, bx, EpiStore{PB, PLD}); } if ((REPMASK >> 2) & 1) { run_gemm(lds, HB, wb + WO_WIN0 / 2, T, 3072, 1024, G, bx, EpiStore{PB, PLD}); } }
    SEAM(2);
    if (IN(3)) { { scan_passA(a, lds); ag_rows(a, 240, G - 240, 0, T / 16); } if ((REPMASK >> 3) & 1) { scan_passA(a, lds); ag_rows(a, 240, G - 240, 0, T / 16); } }
    if (IN(3)) conv_l1_tiles(a, lds, CJ0, CJ4 + 528);
    SEAM(3);
    if (IN(4)) { { if (bx < 192) scan_passB(a, lds); else run_gemm(lds, (const bf16_t*)(ws + OFF_AG), wb + WO_BG / 2, T, 1024, 384, G - 192, bx - 192, EpiStore{HB, D}); } if ((REPMASK >> 4) & 1) { if (bx < 192) scan_passB(a, lds); else run_gemm(lds, (const bf16_t*)(ws + OFF_AG), wb + WO_BG / 2, T, 1024, 384, G - 192, bx - 192, EpiStore{HB, D}); } }
    SEAM(4);
    if (IN(5)) { { scan_passC(a, lds); } if ((REPMASK >> 5) & 1) { scan_passC(a, lds); } }
    if (IN(5)) conv_l1_tiles(a, lds, CJ4 + 528, CJ9);
    SEAM(5);
    if (IN(6)) { { readout_rows(a); } if ((REPMASK >> 6) & 1) { readout_rows(a); } }
    SEAM(6);
    if (IN(7)) { { { run_gemm(lds, HB, wb + WO_WO0 / 2, TL, 1024, 1024, G, bx, EpiRes{a.in[0], a.in[2], modr + 2 * 1024, modr + 6144 + 2 * 1024, Z}); if (bx < 16) { const int sl = bx >> 2; run_slice(lds, HB + (size_t)TL * 1024 + sl * 256, wb + WO_WO0 / 2 + sl * 256, 1024, bx & 3, EpiPart{PART + (size_t)sl * 256 * D}); } } } if ((REPMASK >> 7) & 1) { { run_gemm(lds, HB, wb + WO_WO0 / 2, TL, 1024, 1024, G, bx, EpiRes{a.in[0], a.in[2], modr + 2 * 1024, modr + 6144 + 2 * 1024, Z}); if (bx < 16) { const int sl = bx >> 2; run_slice(lds, HB + (size_t)TL * 1024 + sl * 256, wb + WO_WO0 / 2 + sl * 256, 1024, bx & 3, EpiPart{PART + (size_t)sl * 256 * D}); } } } }
    SEAM(7);
    if (IN(8)) { { ln_pass(Z, T, lng, lnb, XA, HB, modr, 3, 4, PART, 4, a.in[2], modr + 6144 + 2 * 1024); } if ((REPMASK >> 8) & 1) { ln_pass(Z, T, lng, lnb, XA, HB, modr, 3, 4, PART, 4, a.in[2], modr + 6144 + 2 * 1024); } }
    SEAM(8);
    if (IN(9)) { { run_gemm(lds, HB, wb + WO_WUP0 / 2, T, 2 * DFF, 1024, G, bx, EpiSwiglu{HID}); } if ((REPMASK >> 9) & 1) { run_gemm(lds, HB, wb + WO_WUP0 / 2, T, 2 * DFF, 1024, G, bx, EpiSwiglu{HID}); } }
    SEAM(9);
    if (IN(10)) { { { run_gemm(lds, HID, wb + WO_WDN0 / 2, TL, 1024, DFF, G, bx, EpiRes{XA, XA + (size_t)TL * D, modr + 5 * 1024, modr + 6144 + 5 * 1024, Z}); if (bx < 44) { const int sl = bx >> 2; run_slice(lds, HID + (size_t)TL * DFF + sl * 256, wb + WO_WDN0 / 2 + sl * 256, DFF, bx & 3, EpiPart{PART + (size_t)sl * 256 * D}); } } } if ((REPMASK >> 10) & 1) { { run_gemm(lds, HID, wb + WO_WDN0 / 2, TL, 1024, DFF, G, bx, EpiRes{XA, XA + (size_t)TL * D, modr + 5 * 1024, modr + 6144 + 5 * 1024, Z}); if (bx < 44) { const int sl = bx >> 2; run_slice(lds, HID + (size_t)TL * DFF + sl * 256, wb + WO_WDN0 / 2 + sl * 256, DFF, bx & 3, EpiPart{PART + (size_t)sl * 256 * D}); } } } }
    SEAM(10);
    if (IN(11)) { { ln_pass(Z, T, lng + 1024, lnb + 1024, XA, HB, modr + 2 * 6144, 0, 1, PART, 11, XA + (size_t)TL * D, modr + 6144 + 5 * 1024); } if ((REPMASK >> 11) & 1) { ln_pass(Z, T, lng + 1024, lnb + 1024, XA, HB, modr + 2 * 6144, 0, 1, PART, 11, XA + (size_t)TL * D, modr + 6144 + 5 * 1024); } }
    SEAM(11);
    if (IN(12)) { { run_gemm(lds, HB, wb + WO_WIN1 / 2, T, 3072, 1024, G, bx, EpiQKV{(bf16_t*)(ws + OFF_QK), (bf16_t*)(ws + OFF_VT)}); } if ((REPMASK >> 12) & 1) { run_gemm(lds, HB, wb + WO_WIN1 / 2, T, 3072, 1024, G, bx, EpiQKV{(bf16_t*)(ws + OFF_QK), (bf16_t*)(ws + OFF_VT)}); } }
    SEAM(12);
    if (IN(13)) { { natten(a, lds); } if ((REPMASK >> 13) & 1) { natten(a, lds); } }
    SEAM(13);
    if (IN(14)) { { run_gemm(lds, HB, wb + WO_WO1 / 2, TL, 1024, 1024, G, bx, EpiRes{XA, XA + (size_t)TL * D, modr + 2 * 6144 + 2 * 1024, modr + 3 * 6144 + 2 * 1024, Z}); } if ((REPMASK >> 14) & 1) { run_gemm(lds, HB, wb + WO_WO1 / 2, TL, 1024, 1024, G, bx, EpiRes{XA, XA + (size_t)TL * D, modr + 2 * 6144 + 2 * 1024, modr + 3 * 6144 + 2 * 1024, Z}); } }
    SEAM(14);
    if (IN(15)) { { ln_pass(Z, TL, lng + 2048, lnb + 2048, XA, HB, modr + 2 * 6144, 3, 4); } if ((REPMASK >> 15) & 1) { ln_pass(Z, TL, lng + 2048, lnb + 2048, XA, HB, modr + 2 * 6144, 3, 4); } }
    SEAM(15);
    if (IN(16)) { { run_gemm(lds, HB, wb + WO_WUP1 / 2, TL, 2 * DFF, 1024, G, bx, EpiSwiglu{HID}); } if ((REPMASK >> 16) & 1) { run_gemm(lds, HB, wb + WO_WUP1 / 2, TL, 2 * DFF, 1024, G, bx, EpiSwiglu{HID}); } }
    SEAM(16);
    if (IN(17)) { { run_gemm(lds, HID, wb + WO_WDN1 / 2, TL, 1024, DFF, G, bx, EpiRes{XA, XA + (size_t)TL * D, modr + 2 * 6144 + 5 * 1024, modr + 3 * 6144 + 5 * 1024, Z}); } if ((REPMASK >> 17) & 1) { run_gemm(lds, HID, wb + WO_WDN1 / 2, TL, 1024, DFF, G, bx, EpiRes{XA, XA + (size_t)TL * D, modr + 2 * 6144 + 5 * 1024, modr + 3 * 6144 + 5 * 1024, Z}); } }
    SEAM(17);
    if (IN(18)) { { ln_pass(Z, TL, lng + 3072, lnb + 3072, a.out, nullptr, nullptr, 0, 0); } if ((REPMASK >> 18) & 1) { ln_pass(Z, TL, lng + 3072, lnb + 3072, a.out, nullptr, nullptr, 0, 0); } }
}
constexpr int NPHASE = 19;
#ifndef MK_MULTI
#define MK_MULTI 0
#endif
extern "C" void kernel_launch(void* const* d_in, const int* in_sizes, int n_in, void* d_out, int out_size, void* d_ws, size_t ws_size, hipStream_t stream) {
    static int grid = 0;
    if (grid == 0) {
        if (n_in != 29 || out_size != TL * D || ws_size < WS_END) { fprintf(stderr, "kernel_launch: unexpected sizes n_in %d out %d ws %zu (need %zu)\n", n_in, out_size, ws_size, (size_t)WS_END); grid = -1; return; }
        int dev = 0, cus = 0, per_cu = 0;
        hipGetDevice(&dev); hipDeviceGetAttribute(&cus, hipDeviceAttributeMultiprocessorCount, dev);
        if (hipFuncSetAttribute((const void*)mega, hipFuncAttributeMaxDynamicSharedMemorySize, LDS_BYTES) != hipSuccess) { fprintf(stderr, "kernel_launch: hipFuncSetAttribute failed\n"); grid = -1; return; }
        if (hipOccupancyMaxActiveBlocksPerMultiprocessor(&per_cu, (const void*)mega, 512, LDS_BYTES) != hipSuccess || per_cu < 1) { fprintf(stderr, "kernel_launch: occupancy query says %d blocks/CU\n", per_cu); (void)hipGetLastError(); per_cu = 1; }
        grid = cus * (per_cu >= 1 ? 1 : 0);
        if (grid != 256) { fprintf(stderr, "kernel_launch: built for a 256-CU device, got %d\n", grid); if (grid > 256) grid = 256; }
    }
    if (grid < 240) return;
    if (hipMemsetAsync((char*)d_ws + OFF_BAR, 0, XCD_BAR_WORDS * 4, stream) != hipSuccess) { fprintf(stderr, "kernel_launch: memset of barrier words failed\n"); return; }
    Args a{};
    for (int i = 0; i < 29; ++i) a.in[i] = (const float*)d_in[i];
    a.out = (float*)d_out; a.ws = (unsigned char*)d_ws;
#if MK_MULTI
    for (int k = 0; k < NPHASE; ++k) { a.lo = k; a.hi = k + 1; hipLaunchKernelGGL(mega, dim3(grid), dim3(512), LDS_BYTES, stream, a); }
#else
    a.lo = 0; a.hi = NPHASE;
    void* args[] = {&a};
    hipError_t e = hipLaunchCooperativeKernel((const void*)mega, dim3(grid), dim3(512), args, LDS_BYTES, stream);
    if (e != hipSuccess) fprintf(stderr, "kernel_launch: cooperative launch failed: %s (grid %d)\n", hipGetErrorString(e), grid);
#endif
}
```
